# Optimizing an MI355X kernel written in HIP

```python
import math
import jax, jax.numpy as jnp
from jax import lax
import numpy as np

D_MODEL = 1024
BATCH = 2
SEQ = 8192
DEPTH = 2

D_MIX = D_MODEL
D_FF = int(math.ceil(8 * D_MODEL / 3 / 256)) * 256
EPS = 1e-6
S5_W = D_MIX // 4
S5_GROUP = 16
S5_G = S5_W // S5_GROUP
S5_P = 64
HG_W = D_MIX // 4
HG_HEADS = 4
HG_DK = HG_W // HG_HEADS
HG_DV = HG_W // HG_HEADS
HG_CHUNK = 64
NSA_W = D_MIX - S5_W - HG_W
NSA_DH = 64
NSA_H = NSA_W // NSA_DH
NSA_G = 2
NSA_R = NSA_H // NSA_G
CMP_LEN = 32
CMP_STRIDE = 16
CMP_RATIO = CMP_LEN // CMP_STRIDE
SLC_LEN = 64
SLC_RATIO = SLC_LEN // CMP_STRIDE
N_SEL = 16
WIN = 512
Q_BLOCK = 128
FORCE_BONUS = 1e4
NEG_INF = -1e30
TINY = 1e-30
REL_BUCKETS = 32
REL_MAX_DIST = 1024
KV_W = NSA_G * NSA_DH
D_IN = S5_W + 4 * HG_W + NSA_W + 6 * KV_W + 3 * NSA_H

kernel_name = 'hymba_s5_hgrn2_nsa_macaron'


def rmsnorm(x, g):
    xf = x.astype(jnp.float32)
    y = xf * lax.rsqrt(jnp.mean(xf * xf, axis=-1, keepdims=True) + EPS)
    return y.astype(x.dtype) * g


def swiglu(h, wg, wu, wd):
    return (jax.nn.silu(h @ wg) * (h @ wu)) @ wd


def masked_softmax(s, mask):
    s = jnp.where(mask, s.astype(jnp.float32), NEG_INF)
    m = jnp.max(s, axis=-1, keepdims=True)
    e = jnp.where(mask, jnp.exp(s - m), 0.0)
    return e / jnp.maximum(jnp.sum(e, axis=-1, keepdims=True), TINY)


def t5_bucket(dist):
    n = jnp.maximum(dist, 0)
    max_exact = REL_BUCKETS // 2
    nf = jnp.maximum(n, max_exact).astype(jnp.float32)
    large = max_exact + (jnp.log(nf / max_exact) / math.log(REL_MAX_DIST / max_exact)
                         * (REL_BUCKETS - max_exact)).astype(jnp.int32)
    large = jnp.minimum(large, REL_BUCKETS - 1)
    return jnp.where(n < max_exact, n, large)


def s5_mixer(u, lam_re, lam_im, log_dt, b_re, b_im, c_re, c_im, d, w_glu):
    B_, L, _ = u.shape
    ug = u.astype(jnp.float32).reshape(B_, L, S5_G, S5_GROUP)
    lr, li = lam_re.astype(jnp.float32), lam_im.astype(jnp.float32)
    dt = jnp.exp(log_dt.astype(jnp.float32))[:, None]
    mag = jnp.exp(lr * dt)
    ab_re, ab_im = mag * jnp.cos(li * dt), mag * jnp.sin(li * dt)
    den = lr * lr + li * li
    nr, ni = ab_re - 1.0, ab_im
    g_re = (nr * lr + ni * li) / den
    g_im = (ni * lr - nr * li) / den
    br, bi = b_re.astype(jnp.float32), b_im.astype(jnp.float32)
    bb_re = g_re[..., None] * br - g_im[..., None] * bi
    bb_im = g_re[..., None] * bi + g_im[..., None] * br
    bu_re = jnp.einsum('blgh,gph->blgp', ug, bb_re)
    bu_im = jnp.einsum('blgh,gph->blgp', ug, bb_im)
    a_re = jnp.broadcast_to(ab_re, bu_re.shape)
    a_im = jnp.broadcast_to(ab_im, bu_im.shape)

    def combine(e1, e2):
        a1r, a1i, b1r, b1i = e1
        a2r, a2i, b2r, b2i = e2
        return (a2r * a1r - a2i * a1i, a2r * a1i + a2i * a1r,
                a2r * b1r - a2i * b1i + b2r, a2r * b1i + a2i * b1r + b2i)

    _, _, xr, xi = lax.associative_scan(combine, (a_re, a_im, bu_re, bu_im), axis=1)
    y = (jnp.einsum('blgp,ghp->blgh', xr, c_re.astype(jnp.float32))
         - jnp.einsum('blgp,ghp->blgh', xi, c_im.astype(jnp.float32))
         + d.astype(jnp.float32) * ug)
    y = jax.nn.gelu(y.reshape(B_, L, S5_W))
    y = y * jax.nn.sigmoid(y @ w_glu.astype(jnp.float32))
    return y.astype(u.dtype)


def hgrn2_mixer(q, f_logit, i_in, g, lb, norm_gain):
    B_, L, _ = q.shape
    nc = L // HG_CHUNK
    qf = jax.nn.silu(q.astype(jnp.float32))
    lbf = lb.astype(jnp.float32)
    fl = f_logit.astype(jnp.float32)
    f = lbf + (1.0 - lbf) * jax.nn.sigmoid(fl)
    lf = jnp.log(jnp.maximum(f, TINY))
    kf = (1.0 - lbf) * jax.nn.sigmoid(-fl)
    vf = i_in.astype(jnp.float32)

    def to_chunks(a, dim):
        return a.reshape(B_, nc, HG_CHUNK, HG_HEADS, dim).transpose(1, 0, 3, 2, 4)

    causal = jnp.tril(jnp.ones((HG_CHUNK, HG_CHUNK), bool))[:, :, None]

    def step(S, inp):
        qc, kc, vc, lfc = inp
        b = jnp.cumsum(lfc, axis=2)
        diff = b[:, :, :, None, :] - b[:, :, None, :, :]
        decay = jnp.where(causal, jnp.exp(jnp.minimum(diff, 0.0)), 0.0)
        att = jnp.einsum('bhtd,bhsd,bhtsd->bhts', qc, kc, decay)
        o = att @ vc + jnp.einsum('bhtd,bhde->bhte', qc * jnp.exp(b), S)
        b_last = b[:, :, -1:, :]
        S = (jnp.exp(b_last[:, :, 0, :, None]) * S
             + jnp.einsum('bhsd,bhse->bhde', kc * jnp.exp(b_last - b), vc))
        return S, o

    S0 = jnp.zeros((B_, HG_HEADS, HG_DK, HG_DV), jnp.float32)
    _, o = lax.scan(step, S0, (to_chunks(qf, HG_DK), to_chunks(kf, HG_DK),
                               to_chunks(vf, HG_DV), to_chunks(lf, HG_DK)))
    o = o.transpose(1, 0, 3, 2, 4).reshape(B_, L, HG_HEADS, HG_DV)
    o = o * lax.rsqrt(jnp.mean(o * o, axis=-1, keepdims=True) + EPS) * norm_gain.astype(jnp.float32)
    o = o.reshape(B_, L, HG_W) * jax.nn.silu(g.astype(jnp.float32))
    return o.astype(q.dtype)


def compress_blocks(k, pos, w1, w2):
    B_, L = k.shape[0], k.shape[1]
    ch = k.reshape(B_, L // CMP_STRIDE, CMP_STRIDE, NSA_G, NSA_DH)
    n = L // CMP_STRIDE - CMP_RATIO + 1
    blocks = jnp.concatenate([ch[:, r:r + n] for r in range(CMP_RATIO)], axis=2)
    blocks = blocks + pos[None, None, :, None, :]
    flat = blocks.transpose(0, 1, 3, 2, 4).reshape(B_, n, NSA_G, CMP_LEN * NSA_DH)
    return jax.nn.gelu(flat @ w1) @ w2


def nsa_mixer(q, kv, gate_logits, pos_k, w1_k, w2_k, pos_v, w1_v, w2_v, rel_bias):
    B_, L, _ = q.shape
    qh = q.reshape(B_, L, NSA_G, NSA_R, NSA_DH)
    kvh = kv.reshape(B_, L, 6, NSA_G, NSA_DH)
    k_cr, v_cr, k_sl, v_sl, k_wn, v_wn = (kvh[:, :, j] for j in range(6))
    gates = jax.nn.sigmoid(gate_logits.astype(jnp.float32)).reshape(B_, L, NSA_G, NSA_R, 3)
    k_cmp = compress_blocks(k_cr, pos_k, w1_k, w2_k)
    v_cmp = compress_blocks(v_cr, pos_v, w1_v, w2_v)
    ncmp = k_cmp.shape[1]
    nsb = L // SLC_LEN
    n_sel = min(N_SEL, nsb)

    def sel_blocks(a):
        return a.reshape(B_, nsb, SLC_LEN, NSA_G, NSA_DH).transpose(0, 3, 1, 2, 4).reshape(
            B_, NSA_G, nsb, SLC_LEN * NSA_DH)

    k_blk, v_blk = sel_blocks(k_sl), sel_blocks(v_sl)
    k_wp = jnp.pad(k_wn, ((0, 0), (WIN, 0), (0, 0), (0, 0)))
    v_wp = jnp.pad(v_wn, ((0, 0), (WIN, 0), (0, 0), (0, 0)))
    tab = rel_bias.astype(jnp.float32)
    tab_g = tab.reshape(REL_BUCKETS, NSA_G, NSA_R).transpose(1, 0, 2)
    cmp_end = jnp.arange(ncmp) * CMP_STRIDE + CMP_LEN - 1
    blk = jnp.arange(nsb)
    tok = jnp.arange(SLC_LEN)
    scale = NSA_DH ** -0.5
    span = SLC_RATIO * (nsb - 1) + 1
    gidx = jnp.arange(NSA_G)[None, :, None, None]

    def dense_bias(dist):
        return jnp.moveaxis(tab[t5_bucket(dist)], -1, 0).reshape(NSA_G, NSA_R, *dist.shape)

    def one_block(qi):
        q0 = qi * Q_BLOCK
        qb = lax.dynamic_slice_in_dim(qh, q0, Q_BLOCK, axis=1)
        gb = lax.dynamic_slice_in_dim(gates, q0, Q_BLOCK, axis=1)
        t = q0 + jnp.arange(Q_BLOCK)
        d_c = t[:, None] - cmp_end[None, :]
        s = jnp.einsum('bqgrd,bcgd->bgrqc', qb, k_cmp).astype(jnp.float32) * scale + dense_bias(d_c)
        p_cmp = masked_softmax(s, d_c >= 0)
        o_cmp = jnp.einsum('bgrqc,bcgd->bqgrd', p_cmp.astype(v_cmp.dtype), v_cmp)
        imp = jnp.sum(p_cmp, axis=2)
        imp = jnp.pad(imp, ((0, 0), (0, 0), (0, 0), (CMP_RATIO - 1, SLC_RATIO * nsb - ncmp)))
        p_slc = sum(imp[..., m + n:m + n + span:SLC_RATIO]
                    for m in range(SLC_RATIO) for n in range(CMP_RATIO))
        blk_ok = (blk[None, :] * SLC_LEN) <= t[:, None]
        cur = (t // SLC_LEN)[:, None]
        forced = (blk[None, :] == 0) | (blk[None, :] == cur) | (blk[None, :] == cur - 1)
        score = jnp.where(blk_ok, p_slc + jnp.where(forced, FORCE_BONUS, 0.0), NEG_INF)
        _, idx = lax.top_k(score, n_sel)
        idx_f = idx.reshape(B_, NSA_G, Q_BLOCK * n_sel, 1)
        k_sel = jnp.take_along_axis(k_blk, idx_f, axis=2).reshape(B_, NSA_G, Q_BLOCK, n_sel * SLC_LEN, NSA_DH)
        v_sel = jnp.take_along_axis(v_blk, idx_f, axis=2).reshape(B_, NSA_G, Q_BLOCK, n_sel * SLC_LEN, NSA_DH)
        pos = (idx[..., None] * SLC_LEN + tok).reshape(B_, NSA_G, Q_BLOCK, n_sel * SLC_LEN)
        d_s = t[None, None, :, None] - pos
        bias_s = tab_g[gidx, t5_bucket(d_s)].transpose(0, 1, 4, 2, 3)
        s = jnp.einsum('bqgrd,bgqkd->bgrqk', qb, k_sel).astype(jnp.float32) * scale + bias_s
        p = masked_softmax(s, (d_s >= 0)[:, :, None])
        o_slc = jnp.einsum('bgrqk,bgqkd->bqgrd', p.astype(v_sel.dtype), v_sel)
        kw = lax.dynamic_slice_in_dim(k_wp, q0, WIN + Q_BLOCK, axis=1)
        vw = lax.dynamic_slice_in_dim(v_wp, q0, WIN + Q_BLOCK, axis=1)
        pos_w = q0 - WIN + jnp.arange(WIN + Q_BLOCK)
        d_w = t[:, None] - pos_w[None, :]
        ok_w = (d_w >= 0) & (d_w < WIN) & (pos_w[None, :] >= 0)
        s = jnp.einsum('bqgrd,bkgd->bgrqk', qb, kw).astype(jnp.float32) * scale + dense_bias(d_w)
        p = masked_softmax(s, ok_w)
        o_win = jnp.einsum('bgrqk,bkgd->bqgrd', p.astype(vw.dtype), vw)
        o = gb[..., 0:1] * o_cmp + gb[..., 1:2] * o_slc + gb[..., 2:3] * o_win
        return o.astype(q.dtype)

    out = lax.map(one_block, jnp.arange(L // Q_BLOCK))
    return out.transpose(1, 0, 2, 3, 4, 5).reshape(B_, L, NSA_W)


def setup_inputs(seed: int = 0) -> dict:
    key = jax.random.key(seed)
    ks = iter(jax.random.split(key, 40))

    def nrm(shape, scale):
        return jax.random.normal(next(ks), shape, jnp.float32) * scale

    def gain(shape):
        return 1.0 + nrm(shape, 0.02)

    n_idx = jnp.arange(S5_P, dtype=jnp.float32)
    return {
        'x': nrm((BATCH, SEQ, D_MODEL), 1.0),
        'ffn1_norm': gain((DEPTH, D_MODEL)),
        'ffn1_w_gate': nrm((DEPTH, D_MODEL, D_FF), D_MODEL ** -0.5),
        'ffn1_w_up': nrm((DEPTH, D_MODEL, D_FF), D_MODEL ** -0.5),
        'ffn1_w_down': nrm((DEPTH, D_FF, D_MODEL), D_FF ** -0.5),
        'mix_norm': gain((DEPTH, D_MODEL)),
        'w_in': nrm((DEPTH, D_MODEL, D_IN), D_MODEL ** -0.5),
        'w_out': nrm((DEPTH, D_MIX, D_MODEL), D_MIX ** -0.5),
        's5_lambda_re': -0.5 + nrm((DEPTH, S5_G, S5_P), 0.01),
        's5_lambda_im': math.pi * n_idx + nrm((DEPTH, S5_G, S5_P), 0.01),
        's5_log_dt': jax.random.uniform(next(ks), (DEPTH, S5_G), jnp.float32,
                                        minval=math.log(0.001), maxval=math.log(0.1)),
        's5_b_re': nrm((DEPTH, S5_G, S5_P, S5_GROUP), (2 * S5_GROUP) ** -0.5),
        's5_b_im': nrm((DEPTH, S5_G, S5_P, S5_GROUP), (2 * S5_GROUP) ** -0.5),
        's5_c_re': nrm((DEPTH, S5_G, S5_GROUP, S5_P), (2 * S5_P) ** -0.5),
        's5_c_im': nrm((DEPTH, S5_G, S5_GROUP, S5_P), (2 * S5_P) ** -0.5),
        's5_d': nrm((DEPTH, S5_G, S5_GROUP), 1.0),
        's5_w_glu': nrm((DEPTH, S5_W, S5_W), S5_W ** -0.5),
        'hgrn_lb_logits': nrm((DEPTH, HG_W), 1.0),
        'hgrn_norm': gain((DEPTH, HG_DV)),
        'nsa_cmp_pos_k': nrm((DEPTH, CMP_LEN, NSA_DH), 0.02),
        'nsa_cmp_w1_k': nrm((DEPTH, CMP_LEN * NSA_DH, NSA_DH), (CMP_LEN * NSA_DH) ** -0.5),
        'nsa_cmp_w2_k': nrm((DEPTH, NSA_DH, NSA_DH), NSA_DH ** -0.5),
        'nsa_cmp_pos_v': nrm((DEPTH, CMP_LEN, NSA_DH), 0.02),
        'nsa_cmp_w1_v': nrm((DEPTH, CMP_LEN * NSA_DH, NSA_DH), (CMP_LEN * NSA_DH) ** -0.5),
        'nsa_cmp_w2_v': nrm((DEPTH, NSA_DH, NSA_DH), NSA_DH ** -0.5),
        'rel_bias': nrm((REL_BUCKETS, NSA_H), 0.5),
        'ffn2_norm': gain((DEPTH, D_MODEL)),
        'ffn2_w_gate': nrm((DEPTH, D_MODEL, D_FF), D_MODEL ** -0.5),
        'ffn2_w_up': nrm((DEPTH, D_MODEL, D_FF), D_MODEL ** -0.5),
        'ffn2_w_down': nrm((DEPTH, D_FF, D_MODEL), D_FF ** -0.5),
        'final_norm': gain((D_MODEL,)),
    }


def reference(x, ffn1_norm, ffn1_w_gate, ffn1_w_up, ffn1_w_down, mix_norm, w_in, w_out,
              s5_lambda_re, s5_lambda_im, s5_log_dt, s5_b_re, s5_b_im, s5_c_re, s5_c_im, s5_d,
              s5_w_glu, hgrn_lb_logits, hgrn_norm, nsa_cmp_pos_k, nsa_cmp_w1_k, nsa_cmp_w2_k,
              nsa_cmp_pos_v, nsa_cmp_w1_v, nsa_cmp_w2_v, rel_bias, ffn2_norm, ffn2_w_gate,
              ffn2_w_up, ffn2_w_down, final_norm):
    gam = jax.nn.softmax(hgrn_lb_logits.astype(jnp.float32), axis=0)
    lower_bounds = jnp.cumsum(gam, axis=0) - gam[0:1]
    offs = np.cumsum([0, S5_W, HG_W, HG_W, HG_W, HG_W, NSA_W, 6 * KV_W, 3 * NSA_H])
    for l in range(DEPTH):
        x = x + 0.5 * swiglu(rmsnorm(x, ffn1_norm[l]), ffn1_w_gate[l], ffn1_w_up[l], ffn1_w_down[l])
        z = rmsnorm(x, mix_norm[l]) @ w_in[l]
        u_s5, q_hg, f_hg, i_hg, g_hg, q_nsa, kv_nsa, gate_nsa = (
            z[..., int(offs[j]):int(offs[j + 1])] for j in range(8))
        y_s5 = s5_mixer(u_s5, s5_lambda_re[l], s5_lambda_im[l], s5_log_dt[l], s5_b_re[l], s5_b_im[l],
                        s5_c_re[l], s5_c_im[l], s5_d[l], s5_w_glu[l])
        y_hg = hgrn2_mixer(q_hg, f_hg, i_hg, g_hg, lower_bounds[l], hgrn_norm[l])
        y_nsa = nsa_mixer(q_nsa, kv_nsa, gate_nsa, nsa_cmp_pos_k[l], nsa_cmp_w1_k[l], nsa_cmp_w2_k[l],
                          nsa_cmp_pos_v[l], nsa_cmp_w1_v[l], nsa_cmp_w2_v[l], rel_bias)
        y = jnp.concatenate([y_s5, y_hg, y_nsa], axis=-1).astype(x.dtype)
        x = x + y @ w_out[l]
        x = x + 0.5 * swiglu(rmsnorm(x, ffn2_norm[l]), ffn2_w_gate[l], ffn2_w_up[l], ffn2_w_down[l])
    return rmsnorm(x, final_norm)
```

```cpp
#include <hip/hip_runtime.h>
#include <hip/hip_cooperative_groups.h>
#include <cstdio>
#include <cstdint>
namespace cg = cooperative_groups;

typedef unsigned short bf16_t;
typedef float f32x4 __attribute__((ext_vector_type(4)));
__device__ __forceinline__ int tidx() { int t = __builtin_amdgcn_workitem_id_x(); asm volatile("" : "+v"(t)); return t; }

constexpr int BSZ = 2, SEQ = 8192, DM = 1024, MTOK = BSZ * SEQ, DFF = 2816, DIN = 2584, ZLD = 2816;
constexpr int NT = 512, NWAVE = 8;
constexpr int LDS_BYTES = 147456;
constexpr float EPS = 1e-6f;
constexpr int ZC_U = 0, ZC_HQ = 256, ZC_HF = 512, ZC_HI = 768, ZC_HG = 1024, ZC_NQ = 1280, ZC_NKV = 1792, ZC_NG = 2560;
constexpr int NCMP = 511;

constexpr size_t MiB = 1u << 20;
constexpr size_t WS_CTL = 0;
constexpr size_t WS_W = 1 * MiB;
constexpr size_t W_GU1 = 0, W_D1 = 11 * MiB, W_IN = W_D1 + 5632 * 1024, W_OUT = W_IN + 5632 * 1024, W_GU2 = W_OUT + 2 * MiB, W_D2 = W_GU2 + 11 * MiB, W_LAYER = W_D2 + 5632 * 1024;
constexpr size_t WS_SMALL = WS_W + 2 * W_LAYER;
constexpr size_t SM_SSQ = 0;
constexpr size_t SM_S5AB = 1048576;
constexpr size_t SM_S5_LAYER = 139264;
constexpr size_t SM_LB = SM_S5AB + 2 * SM_S5_LAYER;
constexpr size_t SM_KC = SM_LB + 2048;
constexpr size_t SM_VC = SM_KC + 524288;
constexpr size_t SM_A64 = SM_VC + 524288;
constexpr size_t SM_WGLU = SM_A64 + 16384;
constexpr size_t SM_W1T = SM_WGLU + 262144;
constexpr size_t SM_W2T = SM_W1T + 1048576;
constexpr size_t SM_POSB = SM_W2T + 32768;
constexpr size_t SM_END = SM_POSB + 1024;
static_assert(SM_END <= 4 * MiB, "small region");
constexpr size_t WS_XB = WS_SMALL + 4 * MiB;
constexpr size_t WS_HG_DS = 0, WS_HG_ST = 16 * MiB, WS_HG_GAM = 24 * MiB;
constexpr size_t WS_HZ = WS_XB + 32 * MiB;
constexpr size_t WS_Y = WS_HZ + 88 * MiB;
constexpr size_t WS_S5T = WS_Y + 32 * MiB;
constexpr size_t WS_END = WS_S5T + 2 * 8921088;
constexpr size_t WS_POW = WS_Y;
constexpr size_t WS_S5_XE = 25 * MiB, WS_S5_XC = 27 * MiB, WS_SELMASK = 28 * MiB;
static_assert(WS_END <= 256 * MiB, "workspace");

struct Params {
    const float* in[31];
    float* X;
    unsigned char* ws;
    int st_lo, st_hi;
};

namespace pg8 {
#define PG8_LAS __attribute__((address_space(3)))
typedef unsigned short bf16_t;
typedef short bf16x8 __attribute__((ext_vector_type(8)));
typedef float f32x4 __attribute__((ext_vector_type(4)));
typedef unsigned u32x4 __attribute__((ext_vector_type(4)));
constexpr int BM = 256, BK = 64, HALF = 128, HTB = HALF * BK * 2  , STAGE_BYTES = 8 * HTB, NXCD = 8, WGM = 8;

__host__ __device__ __forceinline__ int lds_byte(int r, int c) { const int st = (r >> 4) * 2 + (c >> 5), rr = r & 15, cc = c & 31, ob = rr * 64 + cc * 2; return st * 1024 + (ob ^ (((ob >> 9) & 1) << 5)); }
__host__ __device__ __forceinline__ void stage_rc(int b, int& R, int& C) { const int st = b / 1024, sb = b % 1024, swz = sb ^ (((sb >> 9) & 1) << 5); R = (st >> 1) * 16 + swz / 64; C = (st & 1) * 32 + (swz % 64) / 2; }
__host__ __device__ __forceinline__ int perm32(int rho) { const int n = rho >> 4, i = rho & 15; return 8 * (i >> 2) + 4 * n + (i & 3); }

struct Unit { int pm, pn; };
struct Gemm { const bf16_t* A; const bf16_t* Bt; int M, N, K, lda; };

struct StaticOrder {
    int nM, nN, nwg, G, c;
    __host__ __device__ void init(int M, int N, int G_, int c_) { nM = M / BM; nN = N / BM; nwg = nM * nN; G = G_; c = c_; }
    __host__ __device__ bool next(int i, Unit& u) const {
        const long L = (long)i * G + c; if (L >= nwg) return false;
        int wgid = (int)L; { const int q = nwg / NXCD, r = nwg % NXCD, xcd = wgid % NXCD, off = wgid / NXCD; wgid = (xcd < r ? xcd * (q + 1) : r * (q + 1) + (xcd - r) * q) + off; }
        const int nig = WGM * nN, gid = wgid / nig, fm = gid * WGM, gsz = (nM - fm) < WGM ? (nM - fm) : WGM;
        u.pm = fm + ((wgid % nig) % gsz); u.pn = (wgid % nig) / gsz; return true;
    }
    __device__ __forceinline__ void a_ready(const Unit&) const {}
    __device__ __forceinline__ void done(const Unit&) const {}
};

__device__ __forceinline__ unsigned cvt_pk_bf16(float lo, float hi) { unsigned r; asm volatile("v_cvt_pk_bf16_f32 %0, %1, %2" : "=v"(r) : "v"(lo), "v"(hi)); return r; }

__device__ __forceinline__ float rstd16(const float* ssq16, int row) {
    const f32x4* s = (const f32x4*)(ssq16 + 16 * (size_t)row);
    const f32x4 a = s[0], b = s[1], c = s[2], d = s[3];
    const float t = ((a[0] + a[1]) + (a[2] + a[3])) + ((b[0] + b[1]) + (b[2] + b[3])) + ((c[0] + c[1]) + (c[2] + c[3])) + ((d[0] + d[1]) + (d[2] + d[3]));
    return __builtin_amdgcn_rsqf(t * (1.0f / 1024.0f) + 1e-6f);
}
__device__ __forceinline__ float silu_f(float x) { return x * __builtin_amdgcn_rcpf(1.0f + __builtin_amdgcn_exp2f(-1.4426950408889634f * x)); }
typedef unsigned u32x2 __attribute__((ext_vector_type(2)));
struct EpiGU {
    static constexpr bool PERM = true, AFTER_DRAIN = false;
    const float* ssq16; bf16_t* H; int ldh;
    __device__ __forceinline__ void operator()(const f32x4 (&acc)[2][2][4][2], const Unit& u, int wr, int wc, int fr, int fq) const {
#pragma unroll
        for (int ai = 0; ai < 2; ++ai)
#pragma unroll
            for (int m = 0; m < 4; ++m) {
                const int row = u.pm * BM + ai * HALF + wr * 64 + m * 16 + fr;
                const float rs = rstd16(ssq16, row);
#pragma unroll
                for (int bj = 0; bj < 2; ++bj) {
                    const int col0 = u.pn * BM + bj * HALF + wc * 32 + 8 * fq;
                    const f32x4 v0 = acc[ai][bj][m][0] * rs, v1 = acc[ai][bj][m][1] * rs;
                    u32x2 w; w.x = cvt_pk_bf16(silu_f(v0[0]) * v0[1], silu_f(v0[2]) * v0[3]); w.y = cvt_pk_bf16(silu_f(v1[0]) * v1[1], silu_f(v1[2]) * v1[3]);
                    *(u32x2*)(H + (size_t)row * ldh + (col0 >> 1)) = w;
                }
            }
    }
};
template <bool WXB = true>
struct EpiResT {
    static constexpr bool PERM = true, AFTER_DRAIN = false;
    const float* Xin; float* X; bf16_t* XB; float* ssq16; float scale;
    __device__ __forceinline__ void operator()(const f32x4 (&acc)[2][2][4][2], const Unit& u, int wr, int wc, int fr, int fq) const {
#pragma unroll
        for (int ai = 0; ai < 2; ++ai)
#pragma unroll
            for (int m = 0; m < 4; ++m) {
                const int row = u.pm * BM + ai * HALF + wr * 64 + m * 16 + fr;
                float ss = 0.f;
#pragma unroll
                for (int bj = 0; bj < 2; ++bj) {
                    const int col0 = u.pn * BM + bj * HALF + wc * 32 + 8 * fq;
                    float* px = X + (size_t)row * 1024 + col0; const float* pi = Xin + (size_t)row * 1024 + col0;
                    f32x4 x0 = *(const f32x4*)pi, x1 = *(const f32x4*)(pi + 4);
                    x0 = x0 + acc[ai][bj][m][0] * scale; x1 = x1 + acc[ai][bj][m][1] * scale;
                    *(f32x4*)px = x0; *(f32x4*)(px + 4) = x1;
                    ss += ((x0[0] * x0[0] + x0[1] * x0[1]) + (x0[2] * x0[2] + x0[3] * x0[3])) + ((x1[0] * x1[0] + x1[1] * x1[1]) + (x1[2] * x1[2] + x1[3] * x1[3]));
                    if (WXB) {
                        u32x4 w; w.x = cvt_pk_bf16(x0[0], x0[1]); w.y = cvt_pk_bf16(x0[2], x0[3]); w.z = cvt_pk_bf16(x1[0], x1[1]); w.w = cvt_pk_bf16(x1[2], x1[3]);
                        *(u32x4*)(XB + (size_t)row * 1024 + col0) = w;
                    }
                }
                ss += __shfl_xor(ss, 16); ss += __shfl_xor(ss, 32);
                if (fq == 0) ssq16[(size_t)row * 16 + u.pn * 4 + wc] = ss;
            }
    }
};
template <bool INF32, bool OUTF32>
struct EpiResB {
    static constexpr bool PERM = true, AFTER_DRAIN = false;
    const float* Xin; float* Xout; bf16_t* XB; float* ssq16; float scale;
    __device__ __forceinline__ void operator()(const f32x4 (&acc)[2][2][4][2], const Unit& u, int wr, int wc, int fr, int fq) const {
#pragma unroll
        for (int ai = 0; ai < 2; ++ai)
#pragma unroll
            for (int m = 0; m < 4; ++m) {
                const int row = u.pm * BM + ai * HALF + wr * 64 + m * 16 + fr;
                float ss = 0.f;
#pragma unroll
                for (int bj = 0; bj < 2; ++bj) {
                    const int col0 = u.pn * BM + bj * HALF + wc * 32 + 8 * fq;
                    f32x4 x0, x1;
                    if (INF32) { const float* pi = Xin + (size_t)row * 1024 + col0; x0 = *(const f32x4*)pi; x1 = *(const f32x4*)(pi + 4); }
                    else {
                        const u32x4 w = *(const u32x4*)(XB + (size_t)row * 1024 + col0);
                        x0 = (f32x4){__uint_as_float(w.x << 16), __uint_as_float(w.x & 0xffff0000u), __uint_as_float(w.y << 16), __uint_as_float(w.y & 0xffff0000u)};
                        x1 = (f32x4){__uint_as_float(w.z << 16), __uint_as_float(w.z & 0xffff0000u), __uint_as_float(w.w << 16), __uint_as_float(w.w & 0xffff0000u)};
                    }
                    x0 = x0 + acc[ai][bj][m][0] * scale; x1 = x1 + acc[ai][bj][m][1] * scale;
                    ss += ((x0[0] * x0[0] + x0[1] * x0[1]) + (x0[2] * x0[2] + x0[3] * x0[3])) + ((x1[0] * x1[0] + x1[1] * x1[1]) + (x1[2] * x1[2] + x1[3] * x1[3]));
                    if (OUTF32) { float* px = Xout + (size_t)row * 1024 + col0; *(f32x4*)px = x0; *(f32x4*)(px + 4) = x1; }
                    else {
                        u32x4 w; w.x = cvt_pk_bf16(x0[0], x0[1]); w.y = cvt_pk_bf16(x0[2], x0[3]); w.z = cvt_pk_bf16(x1[0], x1[1]); w.w = cvt_pk_bf16(x1[2], x1[3]);
                        *(u32x4*)(XB + (size_t)row * 1024 + col0) = w;
                    }
                }
                ss += __shfl_xor(ss, 16); ss += __shfl_xor(ss, 32);
                if (fq == 0) ssq16[(size_t)row * 16 + u.pn * 4 + wc] = ss;
            }
    }
};
struct EpiZ {
    static constexpr bool PERM = true, AFTER_DRAIN = false;
    const float* ssq16; bf16_t* Z; int ldz;
    __device__ __forceinline__ void operator()(const f32x4 (&acc)[2][2][4][2], const Unit& u, int wr, int wc, int fr, int fq) const {
#pragma unroll
        for (int ai = 0; ai < 2; ++ai)
#pragma unroll
            for (int m = 0; m < 4; ++m) {
                const int row = u.pm * BM + ai * HALF + wr * 64 + m * 16 + fr;
                const float rs = rstd16(ssq16, row);
#pragma unroll
                for (int bj = 0; bj < 2; ++bj) {
                    const int col0 = u.pn * BM + bj * HALF + wc * 32 + 8 * fq;
                    const f32x4 v0 = acc[ai][bj][m][0] * rs, v1 = acc[ai][bj][m][1] * rs;
                    u32x4 w; w.x = cvt_pk_bf16(v0[0], v0[1]); w.y = cvt_pk_bf16(v0[2], v0[3]); w.z = cvt_pk_bf16(v1[0], v1[1]); w.w = cvt_pk_bf16(v1[2], v1[3]);
                    *(u32x4*)(Z + (size_t)row * ldz + col0) = w;
                }
            }
    }
};
template <class Epi, class Sched, bool ALIGN_EPI = false, bool SP2 = false, bool LDAK = true>
__device__ __forceinline__ void gemm_phase(PG8_LAS unsigned char* lds, const Gemm g, const Sched& S, const Epi& E) {
    const int tid = tidx(), wid = __builtin_amdgcn_readfirstlane(tid >> 6), lane = tid & 63, wr = wid >> 2, wc = wid & 3, fr = lane & 15, fq = lane >> 4;
    const int K = g.K, nt = K / BK;
    unsigned voffA[2], voffB[2];
#pragma unroll
    for (int i = 0; i < 2; ++i) { int R, C; stage_rc(tid * 16 + i * 8192, R, C); const int Rb = Epi::PERM ? ((R & ~31) + perm32(R & 31)) : R;
        voffA[i] = (unsigned)(R * (LDAK ? K : g.lda) + C) * 2u; voffB[i] = (unsigned)(Rb * K + C) * 2u; }
    const size_t kstep = (size_t)(BK * 2);
    const size_t hstep = (size_t)HALF * K * 2;
    const size_t tstep = 2 * hstep;
    const size_t hstepA = LDAK ? hstep : (size_t)HALF * g.lda * 2, tstepA = 2 * hstepA;
    const unsigned ldsw = (unsigned)wid * 1024u;
    const int aoff = lds_byte(wr * 64 + fr, fq * 8), boff = lds_byte(wc * 32 + fr, fq * 8);
#define PG8_SA(b, h) (((b) * 2 + (h)) * HTB)
#define PG8_SB(b, h) ((4 + (b) * 2 + (h)) * HTB)
#define PG8_STAGE(bufoff, gbase, voff) do { _Pragma("unroll") for (int _i = 0; _i < 2; ++_i) \
        __builtin_amdgcn_global_load_lds((const unsigned*)((const char*)(gbase) + (voff)[_i]), (PG8_LAS unsigned*)(lds + (bufoff) + ldsw + _i * 8192), 16, 0, 0); } while (0)
#define PG8_LDA(dst, b, h) do { _Pragma("unroll") for (int m = 0; m < 4; ++m) _Pragma("unroll") for (int k = 0; k < 2; ++k) dst[m][k] = *(const PG8_LAS bf16x8*)(lds + PG8_SA(b, h) + aoff + m * 2048 + k * 1024); } while (0)
#define PG8_LDB(dst, b, h) do { _Pragma("unroll") for (int n = 0; n < 2; ++n) _Pragma("unroll") for (int k = 0; k < 2; ++k) dst[n][k] = *(const PG8_LAS bf16x8*)(lds + PG8_SB(b, h) + boff + n * 2048 + k * 1024); } while (0)
#define PG8_MMA(ai, bj, At, Bt) do { __builtin_amdgcn_s_setprio(1); _Pragma("unroll") for (int m = 0; m < 4; ++m) _Pragma("unroll") for (int n = 0; n < 2; ++n) _Pragma("unroll") for (int k = 0; k < 2; ++k) \
        acc[ai][bj][m][n] = __builtin_amdgcn_mfma_f32_16x16x32_bf16(Bt[n][k], At[m][k], acc[ai][bj][m][n], 0, 0, 0); __builtin_amdgcn_s_setprio(0); } while (0)
#define PG8_WAIT_V(n) asm volatile("s_waitcnt vmcnt(" #n ")" ::: "memory")
#define PG8_WAIT_L(n) asm volatile("s_waitcnt lgkmcnt(" #n ")" ::: "memory")
#define PG8_BAR __builtin_amdgcn_s_barrier()
#define PG8_SCHED __builtin_amdgcn_sched_barrier(0)
    Unit cur, nxt; int ui = 0;
    if (!S.next(0, cur)) return;
    f32x4 acc[2][2][4][2];
#pragma unroll
    for (int a = 0; a < 2; ++a)
#pragma unroll
        for (int b = 0; b < 2; ++b)
#pragma unroll
            for (int m = 0; m < 4; ++m)
#pragma unroll
                for (int n = 0; n < 2; ++n) acc[a][b][m][n] = (f32x4){0.f, 0.f, 0.f, 0.f};
    bf16x8 At[4][2], B0[2][2], B1[2][2];
    const char* cA = (const char*)g.A + (size_t)cur.pm * tstepA; const char* cB = (const char*)g.Bt + (size_t)cur.pn * tstep;
    S.a_ready(cur);
    if constexpr (SP2) {
        PG8_STAGE(PG8_SB(0, 0), cB, voffB); PG8_STAGE(PG8_SB(0, 1), cB + hstep, voffB); PG8_STAGE(PG8_SA(0, 0), cA, voffA); PG8_STAGE(PG8_SA(0, 1), cA + hstepA, voffA);
        if (wr == 1) PG8_BAR;
        PG8_WAIT_V(2); PG8_BAR;
        PG8_STAGE(PG8_SB(1, 0), cB + kstep, voffB); PG8_STAGE(PG8_SA(1, 0), cA + kstep, voffA); PG8_STAGE(PG8_SB(1, 1), cB + hstep + kstep, voffB);
        PG8_WAIT_V(6); PG8_BAR;
    } else {
        PG8_STAGE(PG8_SB(0, 0), cB, voffB); PG8_STAGE(PG8_SA(0, 0), cA, voffA); PG8_STAGE(PG8_SB(0, 1), cB + hstep, voffB); PG8_STAGE(PG8_SA(0, 1), cA + hstepA, voffA);
        if (wr == 1) PG8_BAR;
        PG8_WAIT_V(4); PG8_BAR;
        PG8_STAGE(PG8_SB(1, 0), cB + kstep, voffB); PG8_STAGE(PG8_SA(1, 0), cA + kstep, voffA); PG8_STAGE(PG8_SB(1, 1), cB + hstep + kstep, voffB);
        PG8_WAIT_V(6); PG8_BAR;
    }
    for (;;) {
        const bool has_next = S.next(ui + 1, nxt);
        const char* nA = has_next ? (const char*)g.A + (size_t)nxt.pm * tstepA : cA; const char* nB = has_next ? (const char*)g.Bt + (size_t)nxt.pn * tstep : cB;
        for (int t = 0; t < nt; t += 2) {
            const bool last = (t == nt - 2);
            const char* a1 = cA + (size_t)(t + 1) * kstep;
            const char* a2 = last ? nA : cA + (size_t)(t + 2) * kstep; const char* b2 = last ? nB : cB + (size_t)(t + 2) * kstep;
            const char* a3 = a2 + kstep; const char* b3 = b2 + kstep;
            if (last && has_next) S.a_ready(nxt);
            if constexpr (SP2) {
            PG8_LDB(B0, 0, 0); PG8_LDB(B1, 0, 1); PG8_SCHED; PG8_LDA(At, 0, 0); PG8_STAGE(PG8_SA(1, 1), a1 + hstepA, voffA);
            PG8_WAIT_V(8); PG8_WAIT_L(0); PG8_BAR; PG8_MMA(0, 0, At, B0); PG8_MMA(0, 1, At, B1); PG8_BAR; PG8_SCHED;
            PG8_LDA(At, 0, 1); PG8_STAGE(PG8_SB(0, 0), b2, voffB); PG8_STAGE(PG8_SB(0, 1), b2 + hstep, voffB); PG8_STAGE(PG8_SA(0, 0), a2, voffA);
            PG8_WAIT_V(8); PG8_WAIT_L(0); PG8_BAR; PG8_MMA(1, 0, At, B0); PG8_MMA(1, 1, At, B1); PG8_BAR; PG8_SCHED;
            PG8_LDB(B0, 1, 0); PG8_LDB(B1, 1, 1); PG8_SCHED; PG8_LDA(At, 1, 0); PG8_STAGE(PG8_SA(0, 1), a2 + hstepA, voffA);
            PG8_WAIT_V(8); PG8_WAIT_L(0); PG8_BAR; PG8_MMA(0, 0, At, B0); PG8_MMA(0, 1, At, B1); PG8_BAR; PG8_SCHED;
            PG8_LDA(At, 1, 1); PG8_STAGE(PG8_SB(1, 0), b3, voffB); PG8_STAGE(PG8_SB(1, 1), b3 + hstep, voffB); PG8_STAGE(PG8_SA(1, 0), a3, voffA);
            PG8_WAIT_V(8); PG8_WAIT_L(0); PG8_BAR; PG8_MMA(1, 0, At, B0); PG8_MMA(1, 1, At, B1); PG8_BAR; PG8_SCHED;
            } else {
            PG8_LDB(B0, 0, 0); PG8_SCHED; PG8_LDA(At, 0, 0); PG8_STAGE(PG8_SA(1, 1), a1 + hstepA, voffA);
            PG8_WAIT_L(8); PG8_BAR; PG8_WAIT_L(0); PG8_MMA(0, 0, At, B0); PG8_BAR; PG8_SCHED;
            PG8_LDB(B1, 0, 1); PG8_STAGE(PG8_SB(0, 0), b2, voffB);
            PG8_BAR; PG8_WAIT_L(0); PG8_MMA(0, 1, At, B1); PG8_BAR;
            PG8_LDA(At, 0, 1); PG8_STAGE(PG8_SA(0, 0), a2, voffA);
            PG8_BAR; PG8_WAIT_L(0); PG8_MMA(1, 0, At, B0); PG8_BAR; PG8_SCHED;
            PG8_STAGE(PG8_SB(0, 1), b2 + hstep, voffB);
            PG8_WAIT_V(6); PG8_BAR; PG8_MMA(1, 1, At, B1); PG8_BAR;
            PG8_LDB(B0, 1, 0); PG8_SCHED; PG8_LDA(At, 1, 0); PG8_STAGE(PG8_SA(0, 1), a2 + hstepA, voffA);
            PG8_WAIT_L(8); PG8_BAR; PG8_WAIT_L(0); PG8_MMA(0, 0, At, B0); PG8_BAR; PG8_SCHED;
            PG8_LDB(B1, 1, 1); PG8_STAGE(PG8_SB(1, 0), b3, voffB);
            PG8_BAR; PG8_WAIT_L(0); PG8_MMA(0, 1, At, B1); PG8_BAR;
            PG8_LDA(At, 1, 1); PG8_STAGE(PG8_SA(1, 0), a3, voffA);
            PG8_BAR; PG8_WAIT_L(0); PG8_MMA(1, 0, At, B0); PG8_BAR; PG8_SCHED;
            PG8_STAGE(PG8_SB(1, 1), b3 + hstep, voffB);
            PG8_WAIT_V(6); PG8_BAR; PG8_MMA(1, 1, At, B1); PG8_BAR;
            }
        }
        if constexpr (ALIGN_EPI) { if (wr == 0) PG8_BAR; }
        if constexpr (!Epi::AFTER_DRAIN) { E(acc, cur, wr, wc, fr, fq); S.done(cur); }
        if (!has_next) break;
#pragma unroll
        for (int a = 0; a < 2; ++a)
#pragma unroll
            for (int b = 0; b < 2; ++b)
#pragma unroll
                for (int m = 0; m < 4; ++m)
#pragma unroll
                    for (int n = 0; n < 2; ++n) acc[a][b][m][n] = (f32x4){0.f, 0.f, 0.f, 0.f};
        cur = nxt; cA = nA; cB = nB; ++ui;
        if constexpr (ALIGN_EPI) { if (wr == 1) PG8_BAR; }
    }
    PG8_WAIT_V(0);
    if constexpr (!ALIGN_EPI) { if (wr == 0) PG8_BAR; }
    PG8_BAR;
    if constexpr (Epi::AFTER_DRAIN) { E.fused(acc, cur, wr, wc, fr, fq, lds, wid, lane); S.done(cur); }
#undef PG8_SA
#undef PG8_SB
#undef PG8_STAGE
#undef PG8_LDA
#undef PG8_LDB
#undef PG8_MMA
#undef PG8_WAIT_V
#undef PG8_WAIT_L
#undef PG8_BAR
#undef PG8_SCHED
}
}

#define WAVE_SYNC() asm volatile("s_waitcnt vmcnt(0) lgkmcnt(0)" ::: "memory")
__device__ __forceinline__ float bf2f(bf16_t v) { return __uint_as_float(((unsigned)v) << 16); }
__device__ __forceinline__ bf16_t f2bf(float f) { unsigned u = __float_as_uint(f); return (bf16_t)((u + 0x7fffu + ((u >> 16) & 1u)) >> 16); }
__device__ __forceinline__ float sigmoidf_(float x) { return 1.f / (1.f + expf(-x)); }
__device__ __forceinline__ float siluf_(float x) { return x * sigmoidf_(x); }
__device__ __forceinline__ float gelu_tanh(float x) { const float x3 = x * x * x; return 0.5f * x * (1.f + tanhf(0.7978845608028654f * (x + 0.044715f * x3))); }
__device__ __forceinline__ float wave_sum(float v) {
#pragma unroll
    for (int o = 1; o < 64; o <<= 1) v += __shfl_xor(v, o);
    return v;
}
__device__ __forceinline__ float wave_max(float v) {
#pragma unroll
    for (int o = 1; o < 64; o <<= 1) v = fmaxf(v, __shfl_xor(v, o));
    return v;
}
__device__ __forceinline__ int t5_bucket(int n) {
    if (n < 16) return n;
    const float v = logf((float)n / 16.f) / 4.1588830833596715f * 16.f;
    int b = 16 + (int)v;
    return b < 31 ? b : 31;
}
__device__ __forceinline__ float rstd_of(const float* ssq, int r) { return pg8::rstd16(ssq, r); }

__device__ __forceinline__ void cw_item(const float* W, int K, int N, const float* gain, bf16_t* Bt, int rs, int ro, float* scr, int item, int lane) {
    const int nblk = (N + 31) >> 5, kb = item / nblk, nbk = item - kb * nblk, k0 = 64 * kb, n0 = 32 * nbk;
    const int nn = n0 + (lane & 31); const bool nok = nn < N;
    float v[32];
    const float* wp = W + (size_t)(k0 + (lane >> 5)) * N + nn;
#pragma unroll
    for (int i = 0; i < 32; ++i) v[i] = nok ? wp[(size_t)(2 * i) * N] : 0.f;
    if (gain) {
#pragma unroll
        for (int i = 0; i < 32; ++i) v[i] *= gain[k0 + 2 * i + (lane >> 5)];
    }
#pragma unroll
    for (int i = 0; i < 32; ++i) scr[(2 * i + (lane >> 5)) * 33 + (lane & 31)] = v[i];
    WAVE_SYNC();
    const int c = lane & 7;
#pragma unroll
    for (int j = 0; j < 4; ++j) {
        const int n = (lane >> 3) + 8 * j; const float* sp = scr + (8 * c) * 33 + n;
        pg8::u32x4 o; o.x = pg8::cvt_pk_bf16(sp[0], sp[33]); o.y = pg8::cvt_pk_bf16(sp[66], sp[99]); o.z = pg8::cvt_pk_bf16(sp[132], sp[165]); o.w = pg8::cvt_pk_bf16(sp[198], sp[231]);
        if (n0 + n < N) *(pg8::u32x4*)(Bt + (size_t)((n0 + n) * rs + ro) * K + k0 + 8 * c) = o;
    }
    WAVE_SYNC();
}
__device__ __forceinline__ void convert_wt(const float* W, int K, int N, const float* gain, bf16_t* Bt, int rs, int ro, float* lds, int& g, int NGW) {
    const int lane = tidx() & 63, wave = tidx() >> 6;
    const int nitems = (K >> 6) * ((N + 31) >> 5);
    float* scr = lds + wave * (64 * 33);
    while (g < nitems) { cw_item(W, K, N, gain, Bt, rs, ro, scr, g, lane); g += NGW; }
    g -= nitems;
}

__device__ __forceinline__ void rowstats(const float* src, float* X, bf16_t* XB, float* SSQ, int bid, int nb) {
    const int wave = tidx() >> 6, lane = tidx() & 63;
    for (int r = bid * NWAVE + wave; r < MTOK; r += nb * NWAVE) {
        float s = 0.f;
#pragma unroll
        for (int j = 0; j < 4; ++j) {
            const f32x4 v = *(const f32x4*)(src + (size_t)r * DM + j * 256 + lane * 4);
            s += (v.x * v.x + v.y * v.y) + (v.z * v.z + v.w * v.w);
            if (X != src) *(f32x4*)(X + (size_t)r * DM + j * 256 + lane * 4) = v;
            ushort4 o; o.x = f2bf(v.x); o.y = f2bf(v.y); o.z = f2bf(v.z); o.w = f2bf(v.w);
            *(ushort4*)(XB + (size_t)r * DM + j * 256 + lane * 4) = o;
        }
        s = wave_sum(s);
        if (lane < 16) SSQ[16 * (size_t)r + lane] = (lane == 0) ? s : 0.f;
    }
}

template <class Epi>
__device__ __forceinline__ void gemm_naive(const bf16_t* A, int lda, const bf16_t* Bt, int ldb, int Mrows, int N, int K, float* lds, int bid, int nb, Epi epi) {
    const int tid = tidx(), tx = tid & 31, ty = tid >> 5;
    float* As = lds;
    float* Bs = lds + 16 * 132;
    const int tn_n = N / 128, ntiles = (Mrows / 128) * tn_n;
    for (int tile = bid; tile < ntiles; tile += nb) {
        const int tm = tile / tn_n, tn = tile % tn_n;
        float acc[8][4];
#pragma unroll
        for (int i = 0; i < 8; ++i)
#pragma unroll
            for (int j = 0; j < 4; ++j) acc[i][j] = 0.f;
        const int lr = tid >> 2, lk = (tid & 3) * 4;
        const bf16_t* ap = A + (size_t)(tm * 128 + lr) * lda + lk;
        const bf16_t* bp = Bt + (size_t)(tn * 128 + lr) * ldb + lk;
        for (int k0 = 0; k0 < K; k0 += 16) {
            const ushort4 av = *(const ushort4*)(ap + k0);
            const ushort4 bv = *(const ushort4*)(bp + k0);
            __syncthreads();
            As[(lk + 0) * 132 + lr] = bf2f(av.x); As[(lk + 1) * 132 + lr] = bf2f(av.y); As[(lk + 2) * 132 + lr] = bf2f(av.z); As[(lk + 3) * 132 + lr] = bf2f(av.w);
            Bs[(lk + 0) * 132 + lr] = bf2f(bv.x); Bs[(lk + 1) * 132 + lr] = bf2f(bv.y); Bs[(lk + 2) * 132 + lr] = bf2f(bv.z); Bs[(lk + 3) * 132 + lr] = bf2f(bv.w);
            __syncthreads();
#pragma unroll 2
            for (int kk = 0; kk < 16; ++kk) {
                const f32x4 a0 = *(const f32x4*)(As + kk * 132 + ty * 8), a1 = *(const f32x4*)(As + kk * 132 + ty * 8 + 4);
                const f32x4 b = *(const f32x4*)(Bs + kk * 132 + tx * 4);
                const float a[8] = {a0.x, a0.y, a0.z, a0.w, a1.x, a1.y, a1.z, a1.w};
#pragma unroll
                for (int i = 0; i < 8; ++i) { acc[i][0] += a[i] * b.x; acc[i][1] += a[i] * b.y; acc[i][2] += a[i] * b.z; acc[i][3] += a[i] * b.w; }
            }
        }
#pragma unroll
        for (int i = 0; i < 8; ++i) epi(tm * 128 + ty * 8 + i, tn * 128 + tx * 4, acc[i]);
    }
}

struct EpiGU { const float* ssq; bf16_t* H;
    __device__ __forceinline__ void operator()(int r, int c, const float* a) const {
        const float rs = rstd_of(ssq, r);
        const float h0 = siluf_(a[0] * rs) * (a[1] * rs), h1 = siluf_(a[2] * rs) * (a[3] * rs);
        ushort2 o; o.x = f2bf(h0); o.y = f2bf(h1);
        *(ushort2*)(H + (size_t)r * DFF + (c >> 1)) = o; } };
struct EpiResid { float* X; float scale;
    __device__ __forceinline__ void operator()(int r, int c, const float* a) const {
        f32x4* p = (f32x4*)(X + (size_t)r * DM + c); f32x4 v = *p;
        v.x += scale * a[0]; v.y += scale * a[1]; v.z += scale * a[2]; v.w += scale * a[3]; *p = v; } };
struct EpiZ { const float* ssq; bf16_t* Z;
    __device__ __forceinline__ void operator()(int r, int c, const float* a) const {
        const float rs = rstd_of(ssq, r);
        ushort4 o; o.x = f2bf(a[0] * rs); o.y = f2bf(a[1] * rs); o.z = f2bf(a[2] * rs); o.w = f2bf(a[3] * rs);
        *(ushort4*)(Z + (size_t)r * ZLD + c) = o; } };

__device__ __forceinline__ void s5_tables(const Params& p, int l, float* tab  , int gtid, int gthreads) {
    const float* lam_re = p.in[8] + l * 1024; const float* lam_im = p.in[9] + l * 1024; const float* log_dt = p.in[10] + l * 16;
    const float* b_re = p.in[11] + l * 16384; const float* b_im = p.in[12] + l * 16384;
    for (int i = gtid; i < 16384; i += gthreads) {
        const int gp = i >> 4;
        const int g = gp >> 6;
        const float lr = lam_re[gp], li = lam_im[gp], dt = expf(log_dt[g]);
        const float mag = expf(lr * dt), are = mag * cosf(li * dt), aim = mag * sinf(li * dt);
        const float den = lr * lr + li * li, nr = are - 1.f, ni = aim;
        const float gre = (nr * lr + ni * li) / den, gim = (ni * lr - nr * li) / den;
        const float br = b_re[i], bi = b_im[i];
        tab[2048 + i] = gre * br - gim * bi;
        tab[2048 + 16384 + i] = gre * bi + gim * br;
        if ((i & 15) == 0) { tab[gp] = are; tab[1024 + gp] = aim; }
    }
}

__device__ __forceinline__ void s5_scan_naive(const Params& p, int l, const bf16_t* Z, float* S5PRE, const float* tab, float* lds, int item  ) {
    const int lane = tidx() & 63;
    const int b = item >> 4, g = item & 15;
    const float* c_re = p.in[13] + l * 16384 + g * 1024;
    const float* c_im = p.in[14] + l * 16384 + g * 1024;
    const float* dsk = p.in[15] + l * 256 + g * 16;
    float* us = lds;
    float* xr = lds + 1024;
    float* xi = xr + 64 * 65;
    float* cre = xi + 64 * 65;
    float* cim = cre + 1024;
    const float are = tab[g * 64 + lane], aim = tab[1024 + g * 64 + lane];
    float bbr[16], bbi[16];
#pragma unroll
    for (int h = 0; h < 16; ++h) { bbr[h] = tab[2048 + (g * 64 + lane) * 16 + h]; bbi[h] = tab[2048 + 16384 + (g * 64 + lane) * 16 + h]; }
    for (int i = lane; i < 1024; i += 64) { cre[i] = c_re[i]; cim[i] = c_im[i]; }
    float sr = 0.f, si = 0.f;
    for (int t0 = 0; t0 < SEQ; t0 += 64) {
        {
            const bf16_t* zp = Z + (size_t)(b * SEQ + t0 + lane) * ZLD + ZC_U + g * 16;
#pragma unroll
            for (int h = 0; h < 16; ++h) us[lane * 16 + h] = bf2f(zp[h]);
        }
        WAVE_SYNC();
        for (int s = 0; s < 64; ++s) {
            float bur = 0.f, bui = 0.f;
#pragma unroll
            for (int h = 0; h < 16; ++h) { const float u = us[s * 16 + h]; bur += u * bbr[h]; bui += u * bbi[h]; }
            const float nr = are * sr - aim * si + bur, ni = are * si + aim * sr + bui;
            sr = nr; si = ni;
            xr[s * 65 + lane] = sr; xi[s * 65 + lane] = si;
        }
        WAVE_SYNC();
        {
            float y[16];
#pragma unroll
            for (int h = 0; h < 16; ++h) y[h] = dsk[h] * us[lane * 16 + h];
            for (int pp = 0; pp < 64; ++pp) {
                const float a = xr[lane * 65 + pp], bq = xi[lane * 65 + pp];
#pragma unroll
                for (int h = 0; h < 16; ++h) y[h] += a * cre[h * 64 + pp] - bq * cim[h * 64 + pp];
            }
            float* o = S5PRE + (size_t)(b * SEQ + t0 + lane) * 256 + g * 16;
#pragma unroll
            for (int h = 0; h < 16; ++h) o[h] = y[h];
        }
        WAVE_SYNC();
    }
}

__device__ __forceinline__ void s5_post_naive(const Params& p, int l, const float* S5PRE, bf16_t* Y, float* lds, int bid, int nb) {
    const float* wglu = p.in[16] + l * 65536;
    const int tid = tidx(), half = tid >> 8, j = tid & 255;
    for (int r0 = bid * 2; r0 < MTOK; r0 += nb * 2) {
        __syncthreads();
        lds[tid] = gelu_tanh(S5PRE[(size_t)(r0 + half) * 256 + j]);
        __syncthreads();
        const float* yg = lds + half * 256;
        float acc = 0.f;
        for (int i = 0; i < 256; ++i) acc += yg[i] * wglu[i * 256 + j];
        Y[(size_t)(r0 + half) * DM + j] = f2bf(yg[j] * sigmoidf_(acc));
    }
}

__device__ __forceinline__ void hgrn_naive(const Params& p, int l, const bf16_t* Z, bf16_t* Y, const float* LB, float* lds, int item  ) {
    const int lane = tidx() & 63;
    const int b = item >> 2, h = item & 3;
    const float lb = LB[l * 256 + h * 64 + lane];
    const float gain = p.in[18][l * 64 + lane];
    float* qs = lds;
    float* fs = qs + 4096;
    float* ks = fs + 4096;
    float* vs = ks + 4096;
    float* gs = vs + 4096;
    float S[64];
#pragma unroll
    for (int d = 0; d < 64; ++d) S[d] = 0.f;
    for (int t0 = 0; t0 < SEQ; t0 += 64) {
        for (int s = 0; s < 64; ++s) {
            const bf16_t* zp = Z + (size_t)(b * SEQ + t0 + s) * ZLD + h * 64 + lane;
            const float q = bf2f(zp[ZC_HQ]), fl = bf2f(zp[ZC_HF]), iv = bf2f(zp[ZC_HI]), gv = bf2f(zp[ZC_HG]);
            qs[s * 64 + lane] = siluf_(q);
            fs[s * 64 + lane] = lb + (1.f - lb) * sigmoidf_(fl);
            ks[s * 64 + lane] = (1.f - lb) * sigmoidf_(-fl);
            vs[s * 64 + lane] = iv;
            gs[s * 64 + lane] = gv;
        }
        WAVE_SYNC();
        for (int s = 0; s < 64; ++s) {
            const float v = vs[s * 64 + lane];
            float o = 0.f;
#pragma unroll
            for (int d = 0; d < 64; d += 4) {
                const f32x4 f4 = *(const f32x4*)(fs + s * 64 + d), k4 = *(const f32x4*)(ks + s * 64 + d), q4 = *(const f32x4*)(qs + s * 64 + d);
                S[d] = f4.x * S[d] + k4.x * v; o += q4.x * S[d];
                S[d + 1] = f4.y * S[d + 1] + k4.y * v; o += q4.y * S[d + 1];
                S[d + 2] = f4.z * S[d + 2] + k4.z * v; o += q4.z * S[d + 2];
                S[d + 3] = f4.w * S[d + 3] + k4.w * v; o += q4.w * S[d + 3];
            }
            const float ms = wave_sum(o * o) * (1.f / 64.f);
            const float on = o * rsqrtf(ms + EPS) * gain * siluf_(gs[s * 64 + lane]);
            Y[(size_t)(b * SEQ + t0 + s) * DM + 256 + h * 64 + lane] = f2bf(on);
        }
        WAVE_SYNC();
    }
}

__device__ __forceinline__ void nsa_compress_naive(const Params& p, int l, const bf16_t* Z, bf16_t* KC, bf16_t* VC, float* lds_wave, int item) {
    const int lane = tidx() & 63;
    const int kv = item & 1, g = (item >> 1) & 1, rest = item >> 2, n = rest % NCMP, b = rest / NCMP;
    const float* pos = p.in[kv ? 22 : 19] + l * 2048;
    const float* w1 = p.in[kv ? 23 : 20] + (size_t)l * 131072;
    const float* w2 = p.in[kv ? 24 : 21] + l * 4096;
    const bf16_t* zp = Z + (size_t)(b * SEQ + 16 * n) * ZLD + ZC_NKV + kv * 128 + g * 64;
    float hsum = 0.f;
    for (int j = 0; j < 32; ++j) {
        const float xv = bf2f(zp[(size_t)j * ZLD + lane]) + pos[j * 64 + lane];
        for (int d = 0; d < 64; ++d) {
            const float xd = __shfl(xv, d);
            hsum += xd * w1[(size_t)(j * 64 + d) * 64 + lane];
        }
    }
    lds_wave[lane] = gelu_tanh(hsum);
    WAVE_SYNC();
    float o = 0.f;
    for (int m = 0; m < 64; ++m) o += lds_wave[m] * w2[m * 64 + lane];
    (kv ? VC : KC)[((size_t)(b * 2 + g) * 512 + n) * 64 + lane] = f2bf(o);
    if (n == 0) (kv ? VC : KC)[((size_t)(b * 2 + g) * 512 + 511) * 64 + lane] = 0;
    WAVE_SYNC();
}

__device__ __forceinline__ void nsa_attn_naive(const bf16_t* Z, const float* KC, const float* VC, bf16_t* Y, const float* btab, float* lw, int item) {
    const int lane = tidx() & 63;
    const int g = item & 1, bt = item >> 1, b = bt / SEQ, t = bt % SEQ;
    float* qs = lw;
    float* pc = lw + 256;
    float* pl = pc + 2048;
    int* sel = (int*)(pl + 256);
    const bf16_t* zrow = Z + (size_t)bt * ZLD;
#pragma unroll
    for (int r = 0; r < 4; ++r) qs[r * 64 + lane] = bf2f(zrow[ZC_NQ + g * 256 + r * 64 + lane]);
    for (int i = lane; i < 2048; i += 64) pc[i] = 0.f;
    WAVE_SYNC();
    const float* bt_g = btab + (g * 4) * 1024;
    float ocmp[4] = {0.f, 0.f, 0.f, 0.f};
    const int nval = t >= 31 ? min((t - 31) / 16 + 1, NCMP) : 0;
    if (nval > 0) {
        const float* kc = KC + (size_t)(b * 2 + g) * 512 * 64;
        const float* vc = VC + (size_t)(b * 2 + g) * 512 * 64;
        for (int i = 0; i < 8; ++i) {
            const int c = lane + 64 * i;
            float a0 = -1e30f, a1 = -1e30f, a2 = -1e30f, a3 = -1e30f;
            if (c < nval) {
                const float* kr = kc + c * 64;
                a0 = 0.f; a1 = 0.f; a2 = 0.f; a3 = 0.f;
#pragma unroll 4
                for (int d = 0; d < 64; ++d) { const float kd = kr[d]; a0 += qs[d] * kd; a1 += qs[64 + d] * kd; a2 += qs[128 + d] * kd; a3 += qs[192 + d] * kd; }
                const int dist = min(t - (16 * c + 31), 1023);
                a0 = a0 * 0.125f + bt_g[dist]; a1 = a1 * 0.125f + bt_g[1024 + dist]; a2 = a2 * 0.125f + bt_g[2048 + dist]; a3 = a3 * 0.125f + bt_g[3072 + dist];
            }
            pc[c] = a0; pc[512 + c] = a1; pc[1024 + c] = a2; pc[1536 + c] = a3;
        }
        for (int r = 0; r < 4; ++r) {
            float m = -1e30f;
            for (int i = 0; i < 8; ++i) m = fmaxf(m, pc[r * 512 + lane + 64 * i]);
            m = wave_max(m);
            float sum = 0.f;
            for (int i = 0; i < 8; ++i) { const int c = lane + 64 * i; const float e = (c < nval) ? expf(pc[r * 512 + c] - m) : 0.f; pc[r * 512 + c] = e; sum += e; }
            sum = wave_sum(sum);
            const float inv = 1.f / fmaxf(sum, 1e-30f);
            for (int i = 0; i < 8; ++i) pc[r * 512 + lane + 64 * i] *= inv;
        }
        WAVE_SYNC();
        for (int c = 0; c < nval; ++c) {
            const float v = vc[c * 64 + lane];
            ocmp[0] += pc[c] * v; ocmp[1] += pc[512 + c] * v; ocmp[2] += pc[1024 + c] * v; ocmp[3] += pc[1536 + c] * v;
        }
    }
    {
        float sc[2];
#pragma unroll
        for (int q = 0; q < 2; ++q) {
            const int j = lane + 64 * q;
            float ps = 0.f;
#pragma unroll
            for (int e = -1; e <= 3; ++e) {
                const int c = 4 * j + e;
                if (c >= 0 && c < NCMP) { const float im = (pc[c] + pc[512 + c]) + (pc[1024 + c] + pc[1536 + c]); ps += (e == -1 || e == 3) ? im : 2.f * im; }
            }
            const int cur = t >> 6;
            const bool ok = (j * 64) <= t, forced = (j == 0) || (j == cur) || (j == cur - 1);
            sc[q] = ok ? ps + (forced ? 1e4f : 0.f) : -1e30f;
        }
        for (int it = 0; it < 16; ++it) {
            float bv; int bi;
            if (sc[0] >= sc[1]) { bv = sc[0]; bi = lane; } else { bv = sc[1]; bi = lane + 64; }
#pragma unroll
            for (int o = 1; o < 64; o <<= 1) {
                const float ov = __shfl_xor(bv, o); const int oi = __shfl_xor(bi, o);
                if (ov > bv || (ov == bv && oi < bi)) { bv = ov; bi = oi; }
            }
            if (lane == 0) sel[it] = bi;
            if (bi == lane) sc[0] = -3e38f;
            if (bi == lane + 64) sc[1] = -3e38f;
        }
        WAVE_SYNC();
    }
    float obr[2][4];
#pragma unroll
    for (int br = 0; br < 2; ++br) {
        float m[4] = {-1e30f, -1e30f, -1e30f, -1e30f}, lsum[4] = {0.f, 0.f, 0.f, 0.f}, o[4] = {0.f, 0.f, 0.f, 0.f};
        const int kcol = ZC_NKV + (br ? 4 : 2) * 128 + g * 64, vcol = kcol + 128;
        const int nblk = br ? 8 : 16;
        for (int ib = 0; ib < nblk; ++ib) {
            const int p0 = br ? (t - 511 + 64 * ib) : sel[ib] * 64;
            if (p0 > t || p0 + 63 < 0) continue;
            const int pos = p0 + lane;
            const bool valid = pos >= 0 && pos <= t;
            float s4[4] = {0.f, 0.f, 0.f, 0.f};
            if (valid) {
                const bf16_t* kr = Z + (size_t)(b * SEQ + pos) * ZLD + kcol;
                for (int d = 0; d < 64; d += 4) {
                    const ushort4 k4 = *(const ushort4*)(kr + d);
                    const float k0 = bf2f(k4.x), k1 = bf2f(k4.y), k2 = bf2f(k4.z), k3 = bf2f(k4.w);
#pragma unroll
                    for (int r = 0; r < 4; ++r) s4[r] += qs[r * 64 + d] * k0 + qs[r * 64 + d + 1] * k1 + qs[r * 64 + d + 2] * k2 + qs[r * 64 + d + 3] * k3;
                }
                const int dist = min(t - pos, 1023);
#pragma unroll
                for (int r = 0; r < 4; ++r) s4[r] = s4[r] * 0.125f + bt_g[r * 1024 + dist];
            }
            float f[4];
#pragma unroll
            for (int r = 0; r < 4; ++r) {
                const float mb = wave_max(valid ? s4[r] : -1e30f);
                const float mn = fmaxf(m[r], mb);
                f[r] = expf(m[r] - mn);
                const float e = valid ? expf(s4[r] - mn) : 0.f;
                lsum[r] = lsum[r] * f[r] + wave_sum(e);
                m[r] = mn;
                pl[r * 64 + lane] = e;
                o[r] *= f[r];
            }
            WAVE_SYNC();
            const int klo = max(0, -p0), khi = min(63, t - p0);
            for (int k = klo; k <= khi; ++k) {
                const float v = bf2f(Z[(size_t)(b * SEQ + p0 + k) * ZLD + vcol + lane]);
                o[0] += pl[k] * v; o[1] += pl[64 + k] * v; o[2] += pl[128 + k] * v; o[3] += pl[192 + k] * v;
            }
            WAVE_SYNC();
        }
#pragma unroll
        for (int r = 0; r < 4; ++r) obr[br][r] = o[r] / fmaxf(lsum[r], 1e-30f);
    }
#pragma unroll
    for (int r = 0; r < 4; ++r) {
        const bf16_t* gp = zrow + ZC_NG + g * 12 + r * 3;
        const float g0 = sigmoidf_(bf2f(gp[0])), g1 = sigmoidf_(bf2f(gp[1])), g2 = sigmoidf_(bf2f(gp[2]));
        Y[(size_t)bt * DM + 512 + g * 256 + r * 64 + lane] = f2bf(g0 * ocmp[r] + g1 * obr[0][r] + g2 * obr[1][r]);
    }
    WAVE_SYNC();
}

__device__ __forceinline__ void final_norm(float* X, const float* ssq, const float* gain, int bid, int nb) {
    const int wave = tidx() >> 6, lane = tidx() & 63;
    for (int r = bid * NWAVE + wave; r < MTOK; r += nb * NWAVE) {
        const float rs = rstd_of(ssq, r);
#pragma unroll
        for (int j = 0; j < 4; ++j) {
            f32x4* px = (f32x4*)(X + (size_t)r * DM + j * 256 + lane * 4);
            const f32x4 gv = *(const f32x4*)(gain + j * 256 + lane * 4);
            f32x4 v = *px; v.x *= rs * gv.x; v.y *= rs * gv.y; v.z *= rs * gv.z; v.w *= rs * gv.w; *px = v;
        }
    }
}

namespace hg {
typedef short bf16x8 __attribute__((ext_vector_type(8)));
typedef unsigned u32x4 __attribute__((ext_vector_type(4)));
constexpr int LDP = 72;
constexpr int OFF_KT = 0, OFF_VT = 9216, OFF_QH = 18432, OFF_QT = 27648, OFF_KV = 36864, OFF_AM = 59904, OFF_O = 69120, OFF_SEG = 86528, HG_LDS = 88576;
__device__ __forceinline__ unsigned pk2(float lo, float hi) { return pg8::cvt_pk_bf16(lo, hi); }
__device__ __forceinline__ bf16x8 ldsfrag(const unsigned char* base, int row, int col) { return *(const bf16x8*)(base + (row * LDP + col) * 2); }

__device__ __forceinline__ void prep(const bf16_t* Z, int item, float lbv, float (&bb)[8], float (&kk)[8], float (&qq)[8], float (&vv)[8],
                                     float& tot, float& r1, float& r2, float& r3, float* seg_lds) {
    const int d = tidx() & 63, seg = tidx() >> 6;
    const int bh = item >> 7, c = item & 127, b_ = bh >> 2, h = bh & 3;
    const bf16_t* zp = Z + (size_t)(b_ * SEQ + c * 64 + seg * 8) * ZLD + h * 64 + d;
    float run = 0.f;
#pragma unroll
    for (int j = 0; j < 8; ++j) {
        const float q = bf2f(zp[(size_t)j * ZLD + ZC_HQ]), fl = bf2f(zp[(size_t)j * ZLD + ZC_HF]), iv = bf2f(zp[(size_t)j * ZLD + ZC_HI]);
        const float e = __expf(-fabsf(fl)), inv = 1.f / (1.f + e);
        const float sig = fl >= 0.f ? inv : e * inv, sigm = fl >= 0.f ? e * inv : inv;
        const float f = lbv + (1.f - lbv) * sig;
        run += __logf(fmaxf(f, 1e-30f));
        bb[j] = run; kk[j] = (1.f - lbv) * sigm; qq[j] = q / (1.f + __expf(-q)); vv[j] = iv;
    }
    seg_lds[seg * 64 + d] = run;
    __syncthreads();
    float pre = 0.f, off = 0.f; r1 = 0.f; r2 = 0.f; r3 = 0.f;
#pragma unroll
    for (int i = 0; i < 8; ++i) {
        if (i == 2) r1 = pre; if (i == 4) r2 = pre; if (i == 6) r3 = pre;
        if (i == seg) off = pre;
        pre += seg_lds[i * 64 + d];
    }
    tot = pre;
#pragma unroll
    for (int j = 0; j < 8; ++j) bb[j] += off;
}

__device__ __forceinline__ void phase1(const bf16_t* Z, const float* LBl, float* DS, float* GAM, unsigned char* lds, int item) {
    const int tid = tidx(), lane = tid & 63, wave = tid >> 6, d = lane, seg = wave;
    const int h = (item >> 7) & 3;
    float bb[8], kk[8], qq[8], vv[8], tot, r1, r2, r3;
    prep(Z, item, LBl[h * 64 + d], bb, kk, qq, vv, tot, r1, r2, r3, (float*)(lds + OFF_SEG));
    {
        float kh[8];
#pragma unroll
        for (int j = 0; j < 8; ++j) kh[j] = kk[j] * __expf(tot - bb[j]);
        u32x4 w; w.x = pk2(kh[0], kh[1]); w.y = pk2(kh[2], kh[3]); w.z = pk2(kh[4], kh[5]); w.w = pk2(kh[6], kh[7]);
        *(u32x4*)(lds + OFF_KT + (d * LDP + 8 * seg) * 2) = w;
        u32x4 v; v.x = pk2(vv[0], vv[1]); v.y = pk2(vv[2], vv[3]); v.z = pk2(vv[4], vv[5]); v.w = pk2(vv[6], vv[7]);
        *(u32x4*)(lds + OFF_VT + (d * LDP + 8 * seg) * 2) = v;
        if (seg == 0) GAM[(size_t)item * 64 + d] = __expf(tot);
    }
    __syncthreads();
    const int row = lane & 15, kq = lane >> 4, mt = wave >> 1;
#pragma unroll
    for (int q = 0; q < 2; ++q) {
        const int nt = (wave & 1) * 2 + q;
        f32x4 acc = (f32x4){0.f, 0.f, 0.f, 0.f};
#pragma unroll
        for (int ks = 0; ks < 2; ++ks) {
            const bf16x8 a = ldsfrag(lds + OFF_VT, 16 * mt + row, 32 * ks + 8 * kq);
            const bf16x8 bq = ldsfrag(lds + OFF_KT, 16 * nt + row, 32 * ks + 8 * kq);
            acc = __builtin_amdgcn_mfma_f32_16x16x32_bf16(a, bq, acc, 0, 0, 0);
        }
        float* o = DS + (size_t)item * 4096 + (16 * mt + 4 * kq) * 64 + 16 * nt + row;
#pragma unroll
        for (int r = 0; r < 4; ++r) o[r * 64] = acc[r];
    }
    __syncthreads();
}

__device__ __forceinline__ void phase2(const float* DS, const float* GAM, bf16_t* ST, int idx  ) {
    const int bh = idx >> 12, ed = idx & 4095, d = ed & 63;
    float S = 0.f;
    for (int c0 = 0; c0 < 128; c0 += 16) {
        float ds[16], gm[16];
#pragma unroll
        for (int j = 0; j < 16; ++j) { ds[j] = DS[(size_t)(bh * 128 + c0 + j) * 4096 + ed]; gm[j] = GAM[(size_t)(bh * 128 + c0 + j) * 64 + d]; }
#pragma unroll
        for (int j = 0; j < 16; ++j) { ST[(size_t)(bh * 128 + c0 + j) * 4096 + ed] = f2bf(S); S = gm[j] * S + ds[j]; }
    }
}

__device__ __forceinline__ void phase3(const bf16_t* Z, const float* LBl, const float* gain, const bf16_t* ST, bf16_t* Y, unsigned char* lds, int item) {
    const int tid = tidx(), lane = tid & 63, wave = tid >> 6, d = lane, seg = wave;
    const int bh = item >> 7, c = item & 127, b_ = bh >> 2, h = bh & 3;
    float bb[8], kk[8], qq[8], vv[8], tot, r1, r2, r3;
    prep(Z, item, LBl[h * 64 + d], bb, kk, qq, vv, tot, r1, r2, r3, (float*)(lds + OFF_SEG));
    {
        u32x4 v; v.x = pk2(vv[0], vv[1]); v.y = pk2(vv[2], vv[3]); v.z = pk2(vv[4], vv[5]); v.w = pk2(vv[6], vv[7]);
        *(u32x4*)(lds + OFF_VT + (d * LDP + 8 * seg) * 2) = v;
        const int it = seg >> 1;
        const float rr[4] = {0.f, r1, r2, r3};
        const float rmine = it == 0 ? 0.f : (it == 1 ? r1 : (it == 2 ? r2 : r3));
        bf16_t* QH = (bf16_t*)(lds + OFF_QH); bf16_t* QT = (bf16_t*)(lds + OFF_QT); bf16_t* KV = (bf16_t*)(lds + OFF_KV);
#pragma unroll
        for (int j = 0; j < 8; ++j) {
            const int t = 8 * seg + j;
            QH[t * LDP + d] = f2bf(qq[j] * __expf(bb[j]));
            QT[t * LDP + d] = f2bf(qq[j] * __expf(bb[j] - rmine));
#pragma unroll
            for (int i = 0; i < 4; ++i) {
                const int base = (i == 0) ? 0 : (i == 1 ? 16 : (i == 2 ? 48 : 96));
                if (i >= it) KV[(base + t) * LDP + d] = f2bf(kk[j] * __expf(rr[i] - bb[j]));
            }
        }
        bf16_t* AM = (bf16_t*)(lds + OFF_AM);
        { const int blk = tid >> 8, e = tid & 255, r = e >> 4, cc = e & 15; AM[(32 * blk + r) * LDP + 16 + 32 * blk + cc] = 0; }
    }
    __syncthreads();
    const int row = lane & 15, kq = lane >> 4;
    {
        bf16_t* AM = (bf16_t*)(lds + OFF_AM);
#pragma unroll
        for (int rep = 0; rep < 2; ++rep) {
            const int blk = wave + 8 * rep;
            if (blk < 10) {
                const int i = blk == 0 ? 0 : (blk < 3 ? 1 : (blk < 6 ? 2 : 3));
                const int j = blk - (i == 0 ? 0 : (i == 1 ? 1 : (i == 2 ? 3 : 6)));
                const int base = (i == 0) ? 0 : (i == 1 ? 16 : (i == 2 ? 48 : 96));
                f32x4 acc = (f32x4){0.f, 0.f, 0.f, 0.f};
#pragma unroll
                for (int ks = 0; ks < 2; ++ks) {
                    const bf16x8 a = ldsfrag(lds + OFF_QT, 16 * i + row, 32 * ks + 8 * kq);
                    const bf16x8 bq = ldsfrag(lds + OFF_KV, base + 16 * j + row, 32 * ks + 8 * kq);
                    acc = __builtin_amdgcn_mfma_f32_16x16x32_bf16(a, bq, acc, 0, 0, 0);
                }
#pragma unroll
                for (int r = 0; r < 4; ++r) {
                    const int tl = 4 * kq + r, sl = row;
                    const float v = (i == j && sl > tl) ? 0.f : acc[r];
                    AM[(16 * i + tl) * LDP + 16 * j + sl] = f2bf(v);
                }
            }
        }
    }
    __syncthreads();
    {
        const int mt = wave >> 1;
        float* O = (float*)(lds + OFF_O);
        const bf16_t* Sg = ST + (size_t)item * 4096;
#pragma unroll
        for (int q = 0; q < 2; ++q) {
            const int nt = (wave & 1) * 2 + q;
            f32x4 acc = (f32x4){0.f, 0.f, 0.f, 0.f};
#pragma unroll
            for (int ks = 0; ks < 2; ++ks) {
                if (ks <= (mt >> 1)) {
                    const bf16x8 a = ldsfrag(lds + OFF_AM, 16 * mt + row, 32 * ks + 8 * kq);
                    const bf16x8 bq = ldsfrag(lds + OFF_VT, 16 * nt + row, 32 * ks + 8 * kq);
                    acc = __builtin_amdgcn_mfma_f32_16x16x32_bf16(a, bq, acc, 0, 0, 0);
                }
            }
#pragma unroll
            for (int ks = 0; ks < 2; ++ks) {
                const bf16x8 a = ldsfrag(lds + OFF_QH, 16 * mt + row, 32 * ks + 8 * kq);
                const bf16x8 bq = *(const bf16x8*)(Sg + (16 * nt + row) * 64 + 32 * ks + 8 * kq);
                acc = __builtin_amdgcn_mfma_f32_16x16x32_bf16(a, bq, acc, 0, 0, 0);
            }
#pragma unroll
            for (int r = 0; r < 4; ++r) O[(16 * mt + 4 * kq + r) * 68 + 16 * nt + row] = acc[r];
        }
    }
    __syncthreads();
    {
        const int t = tid >> 3, e0 = (tid & 7) * 8;
        const float* O = (const float*)(lds + OFF_O) + t * 68 + e0;
        const f32x4 o0 = *(const f32x4*)O, o1 = *(const f32x4*)(O + 4);
        float ss = ((o0[0] * o0[0] + o0[1] * o0[1]) + (o0[2] * o0[2] + o0[3] * o0[3])) + ((o1[0] * o1[0] + o1[1] * o1[1]) + (o1[2] * o1[2] + o1[3] * o1[3]));
        ss += __shfl_xor(ss, 1); ss += __shfl_xor(ss, 2); ss += __shfl_xor(ss, 4);
        const float rs = rsqrtf(ss * (1.f / 64.f) + EPS);
        const size_t tok = (size_t)(b_ * SEQ + c * 64 + t);
        const u32x4 gw = *(const u32x4*)(Z + tok * ZLD + ZC_HG + h * 64 + e0);
        const f32x4 g0 = *(const f32x4*)(gain + e0), g1 = *(const f32x4*)(gain + e0 + 4);
        float ov[8] = {o0[0], o0[1], o0[2], o0[3], o1[0], o1[1], o1[2], o1[3]};
        const float gn[8] = {g0[0], g0[1], g0[2], g0[3], g1[0], g1[1], g1[2], g1[3]};
        const unsigned gwv[4] = {gw.x, gw.y, gw.z, gw.w};
#pragma unroll
        for (int j = 0; j < 8; ++j) {
            const float gv = __uint_as_float((j & 1) ? (gwv[j >> 1] & 0xffff0000u) : (gwv[j >> 1] << 16));
            ov[j] = ov[j] * rs * gn[j] * (gv / (1.f + __expf(-gv)));
        }
        u32x4 w; w.x = pk2(ov[0], ov[1]); w.y = pk2(ov[2], ov[3]); w.z = pk2(ov[4], ov[5]); w.w = pk2(ov[6], ov[7]);
        *(u32x4*)(Y + tok * DM + 256 + h * 64 + e0) = w;
    }
    __syncthreads();
}
}

namespace s5 {
typedef short bf16x8 __attribute__((ext_vector_type(8)));
typedef unsigned u32x4 __attribute__((ext_vector_type(4)));
typedef unsigned u32x2 __attribute__((ext_vector_type(2)));
constexpr size_t T_KT = 0, T_A1 = 532480, T_A2 = T_A1 + 4194304, T_LAYER = T_A2 + 4194304;
constexpr int UPITCH = 2064;
constexpr int OFF_U = 0, OFF_KT = 16 * UPITCH  , S5_LDS = OFF_KT + 65 * 512;

__device__ __forceinline__ void pow_table(const Params& p, float* POW, int gtid, int gthreads) {
    for (int i = gtid; i < 2 * 16 * 65 * 64; i += gthreads) {
        const int pp = i & 63, j = (i >> 6) % 65, lg = i / (65 * 64), g = lg & 15, l = lg >> 4, gp = g * 64 + pp;
        const double lr = (double)p.in[8][l * 1024 + gp], li = (double)p.in[9][l * 1024 + gp], dt = exp((double)p.in[10][l * 16 + g]);
        const double mag = exp(lr * dt * (double)j), ang = li * dt * (double)j;
        POW[2 * (size_t)i] = (float)(mag * cos(ang)); POW[2 * (size_t)i + 1] = (float)(mag * sin(ang));
    }
}
__device__ __forceinline__ void build_tables(const Params& p, int l, const float* POW, const float* tab, unsigned char* T, int gtid, int gthreads) {
    const float2* powl = (const float2*)POW + (size_t)l * 16 * 65 * 64;
    const float* bbr = tab + 2048; const float* bbi = tab + 2048 + 16384;
    const float* c_re = p.in[13] + l * 16384; const float* c_im = p.in[14] + l * 16384;
    bf16_t* KT = (bf16_t*)(T + T_KT); bf16_t* A1 = (bf16_t*)(T + T_A1); bf16_t* A2 = (bf16_t*)(T + T_A2);
    for (int i = gtid; i < 16 * 65 * 256; i += gthreads) {
        const int hi = i & 15, ho = (i >> 4) & 15, li = (i >> 8) % 65, g = i / (65 * 256);
        float acc = 0.f;
        if (li > 0) {
            const float2* pw = powl + (size_t)(g * 65 + li - 1) * 64;
            const float* cr = c_re + (g * 16 + ho) * 64; const float* ci = c_im + (g * 16 + ho) * 64;
#pragma unroll 8
            for (int pp = 0; pp < 64; ++pp) {
                const float2 pq = pw[pp];
                const float br = bbr[(g * 64 + pp) * 16 + hi], bi = bbi[(g * 64 + pp) * 16 + hi];
                acc += cr[pp] * (pq.x * br - pq.y * bi) - ci[pp] * (pq.x * bi + pq.y * br);
            }
        }
        KT[i] = f2bf(acc);
    }
    for (int i = gtid; i < 16 * 64 * 64 * 8; i += gthreads) {
        const int hp = i & 7, s = (i >> 3) & 63, pp = (i >> 9) & 63, g = i >> 15, gp = g * 64 + pp;
        const float2 pq = powl[(size_t)(g * 65 + 63 - s) * 64 + pp];
        const float br0 = bbr[gp * 16 + 2 * hp], bi0 = bbi[gp * 16 + 2 * hp], br1 = bbr[gp * 16 + 2 * hp + 1], bi1 = bbi[gp * 16 + 2 * hp + 1];
        unsigned* o0 = (unsigned*)(A1 + ((size_t)(g * 128 + 2 * pp) * 1024 + s * 16 + 2 * hp));
        o0[0] = pg8::cvt_pk_bf16(pq.x * br0 - pq.y * bi0, pq.x * br1 - pq.y * bi1);
        o0[512] = pg8::cvt_pk_bf16(pq.x * bi0 + pq.y * br0, pq.x * bi1 + pq.y * br1);
    }
    for (int i = gtid; i < 16 * 64 * 16 * 64; i += gthreads) {
        const int pp = i & 63, ho = (i >> 6) & 15, t = (i >> 10) & 63, g = i >> 16;
        const float2 pq = powl[(size_t)(g * 65 + t + 1) * 64 + pp];
        const float cr = c_re[(g * 16 + ho) * 64 + pp], ci = c_im[(g * 16 + ho) * 64 + pp];
        *(unsigned*)(A2 + ((size_t)(g * 1024 + t * 16 + ho) * 128 + 2 * pp)) = pg8::cvt_pk_bf16(cr * pq.x - ci * pq.y, -(cr * pq.y + ci * pq.x));
    }
}
__device__ __forceinline__ void stage_u(const bf16_t* Z, int g, int b_, int cgrp, unsigned char* lds) {
#pragma unroll
    for (int q = 0; q < 4; ++q) {
        const int i = tidx() + 512 * q, n = i >> 7, s = (i >> 1) & 63, half = i & 1;
        const u32x4 v = *(const u32x4*)(Z + (size_t)(b_ * SEQ + (cgrp * 16 + n) * 64 + s) * ZLD + ZC_U + g * 16 + 8 * half);
        *(u32x4*)(lds + OFF_U + n * UPITCH + s * 32 + half * 16) = v;
    }
}
__device__ __forceinline__ bf16x8 ufrag(const unsigned char* lds, int n, int ks, int kq) { return *(const bf16x8*)(lds + OFF_U + n * UPITCH + (2 * ks + (kq >> 1)) * 32 + (kq & 1) * 16); }

__device__ __forceinline__ void phase1(const bf16_t* Z, const unsigned char* T, float* XE, unsigned char* lds, int item) {
    const int lane = tidx() & 63, wave = tidx() >> 6, row = lane & 15, kq = lane >> 4;
    const int g = item >> 4, b_ = (item >> 3) & 1, cgrp = item & 7;
    stage_u(Z, g, b_, cgrp, lds);
    __syncthreads();
    const bf16_t* A1 = (const bf16_t*)(T + T_A1) + (size_t)(g * 128 + 16 * wave + row) * 1024 + 8 * kq;
    f32x4 acc = (f32x4){0.f, 0.f, 0.f, 0.f};
#pragma unroll 8
    for (int ks = 0; ks < 32; ++ks) {
        const bf16x8 a = *(const bf16x8*)(A1 + 32 * ks);
        acc = __builtin_amdgcn_mfma_f32_16x16x32_bf16(a, ufrag(lds, row, ks, kq), acc, 0, 0, 0);
    }
    *(f32x4*)(XE + ((size_t)((b_ * 16 + g) * 128 + cgrp * 16 + row)) * 128 + 16 * wave + 4 * kq) = acc;
    __syncthreads();
}
__device__ __forceinline__ void phase2(const float* XE, const float* A64l  , bf16_t* XC, int idx  ) {
    const int bg = idx >> 6, pp = idx & 63, g = bg & 15;
    const float ar = A64l[(g * 64 + pp) * 2], ai = A64l[(g * 64 + pp) * 2 + 1];
    float xr = 0.f, xi = 0.f;
    for (int c0 = 0; c0 < 128; c0 += 16) {
        float er[16], ei[16];
#pragma unroll
        for (int j = 0; j < 16; ++j) { const float2 e = *(const float2*)(XE + ((size_t)(bg * 128 + c0 + j)) * 128 + 2 * pp); er[j] = e.x; ei[j] = e.y; }
#pragma unroll
        for (int j = 0; j < 16; ++j) {
            *(unsigned*)(XC + ((size_t)(bg * 128 + c0 + j)) * 128 + 2 * pp) = pg8::cvt_pk_bf16(xr, xi);
            const float nr = ar * xr - ai * xi + er[j], ni = ar * xi + ai * xr + ei[j];
            xr = nr; xi = ni;
        }
    }
}
__device__ __forceinline__ void phase3(const Params& p, int l, const bf16_t* Z, const unsigned char* T, const bf16_t* XC, bf16_t* Y, unsigned char* lds, int item) {
    const int tid = tidx(), lane = tid & 63, wave = tid >> 6, row = lane & 15, kq = lane >> 4;
    const int g = item >> 4, b_ = (item >> 3) & 1, cgrp = item & 7;
    stage_u(Z, g, b_, cgrp, lds);
    {
        const u32x4* src = (const u32x4*)(T + T_KT + (size_t)g * 65 * 512);
        for (int i = tid; i < 65 * 32; i += NT) *(u32x4*)(lds + OFF_KT + i * 16) = src[i];
    }
    __syncthreads();
    const bf16_t* xcp = XC + ((size_t)((b_ * 16 + g) * 128 + cgrp * 16 + row)) * 128 + 8 * kq;
    bf16x8 xc[4];
#pragma unroll
    for (int ks = 0; ks < 4; ++ks) xc[ks] = *(const bf16x8*)(xcp + 32 * ks);
    const float* dsk = p.in[15] + l * 256 + g * 16 + 4 * kq;
    const f32x4 dv = *(const f32x4*)dsk;
    for (int q = 0; q < 8; ++q) {
        const int t = 8 * q + ((q & 1) ? (7 - wave) : wave);
        f32x4 acc = (f32x4){0.f, 0.f, 0.f, 0.f};
        const bf16_t* A2 = (const bf16_t*)(T + T_A2) + (size_t)(g * 1024 + t * 16 + row) * 128 + 8 * kq;
#pragma unroll
        for (int ks = 0; ks < 4; ++ks) acc = __builtin_amdgcn_mfma_f32_16x16x32_bf16(*(const bf16x8*)(A2 + 32 * ks), xc[ks], acc, 0, 0, 0);
        const int nks = (t >> 1) + 1;
        for (int ks = 0; ks < nks; ++ks) {
            const int s = 2 * ks + (kq >> 1), li = t - s + 1;
            const bf16x8 a = *(const bf16x8*)(lds + OFF_KT + ((li * 16 + row) * 16 + 8 * (kq & 1)) * 2);
            acc = __builtin_amdgcn_mfma_f32_16x16x32_bf16(a, ufrag(lds, row, ks, kq), acc, 0, 0, 0);
        }
        const size_t tok = (size_t)(b_ * SEQ + (cgrp * 16 + row) * 64 + t);
        const u32x2 uw = *(const u32x2*)(Z + tok * ZLD + ZC_U + g * 16 + 4 * kq);
        const float u0 = __uint_as_float(uw.x << 16), u1 = __uint_as_float(uw.x & 0xffff0000u), u2 = __uint_as_float(uw.y << 16), u3 = __uint_as_float(uw.y & 0xffff0000u);
        const float y0 = gelu_tanh(acc[0] + dv[0] * u0), y1 = gelu_tanh(acc[1] + dv[1] * u1), y2 = gelu_tanh(acc[2] + dv[2] * u2), y3 = gelu_tanh(acc[3] + dv[3] * u3);
        u32x2 w; w.x = pg8::cvt_pk_bf16(y0, y1); w.y = pg8::cvt_pk_bf16(y2, y3);
        *(u32x2*)(Y + tok * DM + g * 16 + 4 * kq) = w;
    }
    __syncthreads();
}
}
namespace pg8 {
struct EpiGLU {
    static constexpr bool PERM = true, AFTER_DRAIN = false;
    bf16_t* Y;
    __device__ __forceinline__ void operator()(const f32x4 (&acc)[2][2][4][2], const Unit& u, int wr, int wc, int fr, int fq) const {
#pragma unroll
        for (int ai = 0; ai < 2; ++ai)
#pragma unroll
            for (int m = 0; m < 4; ++m) {
                const int row = u.pm * BM + ai * HALF + wr * 64 + m * 16 + fr;
#pragma unroll
                for (int bj = 0; bj < 2; ++bj) {
                    const int col0 = u.pn * BM + bj * HALF + wc * 32 + 8 * fq;
                    u32x4* py = (u32x4*)(Y + (size_t)row * 1024 + col0);
                    const u32x4 yw = *py;
                    const unsigned ywv[4] = {yw.x, yw.y, yw.z, yw.w};
                    float o[8];
#pragma unroll
                    for (int j = 0; j < 8; ++j) {
                        const float yv = __uint_as_float((j & 1) ? (ywv[j >> 1] & 0xffff0000u) : (ywv[j >> 1] << 16));
                        const float a = acc[ai][bj][m][j >> 2][j & 3];
                        o[j] = yv * __builtin_amdgcn_rcpf(1.0f + __builtin_amdgcn_exp2f(-1.4426950408889634f * a));
                    }
                    u32x4 w; w.x = cvt_pk_bf16(o[0], o[1]); w.y = cvt_pk_bf16(o[2], o[3]); w.z = cvt_pk_bf16(o[4], o[5]); w.w = cvt_pk_bf16(o[6], o[7]);
                    *py = w;
                }
            }
    }
};
}

__device__ __forceinline__ void nsa_slc_naive(const bf16_t* Z, const unsigned* SELMASK, bf16_t* Y, const float* btab, float* lw, int item) {
    const int lane = tidx() & 63;
    const int g = item & 1, bt = item >> 1, b = bt / SEQ, t = bt % SEQ;
    float* qs = lw; float* pl = lw + 256;
    const bf16_t* zrow = Z + (size_t)bt * ZLD;
#pragma unroll
    for (int r = 0; r < 4; ++r) qs[r * 64 + lane] = bf2f(zrow[ZC_NQ + g * 256 + r * 64 + lane]);
    WAVE_SYNC();
    const float* bt_g = btab + (g * 4) * 1024;
    const unsigned* mk = SELMASK + ((size_t)(b * 2 + g) * SEQ + t) * 4;
    float m[4] = {-1e30f, -1e30f, -1e30f, -1e30f}, lsum[4] = {0.f, 0.f, 0.f, 0.f}, o[4] = {0.f, 0.f, 0.f, 0.f};
    const int kcol = ZC_NKV + 2 * 128 + g * 64, vcol = kcol + 128;
    for (int jb = 0; jb * 64 <= t; ++jb) {
        if (!((mk[jb >> 5] >> (jb & 31)) & 1u)) continue;
        const int p0 = jb * 64, pos = p0 + lane;
        const bool valid = pos <= t;
        float s4[4] = {0.f, 0.f, 0.f, 0.f};
        if (valid) {
            const bf16_t* kr = Z + (size_t)(b * SEQ + pos) * ZLD + kcol;
            for (int d = 0; d < 64; d += 4) {
                const ushort4 k4 = *(const ushort4*)(kr + d);
                const float k0 = bf2f(k4.x), k1 = bf2f(k4.y), k2 = bf2f(k4.z), k3 = bf2f(k4.w);
#pragma unroll
                for (int r = 0; r < 4; ++r) s4[r] += qs[r * 64 + d] * k0 + qs[r * 64 + d + 1] * k1 + qs[r * 64 + d + 2] * k2 + qs[r * 64 + d + 3] * k3;
            }
            const int dist = min(t - pos, 1023);
#pragma unroll
            for (int r = 0; r < 4; ++r) s4[r] = s4[r] * 0.125f + bt_g[r * 1024 + dist];
        }
#pragma unroll
        for (int r = 0; r < 4; ++r) {
            const float mb = wave_max(valid ? s4[r] : -1e30f);
            const float mn = fmaxf(m[r], mb);
            const float f = expf(m[r] - mn);
            const float e = valid ? expf(s4[r] - mn) : 0.f;
            lsum[r] = lsum[r] * f + wave_sum(e);
            m[r] = mn; pl[r * 64 + lane] = e; o[r] *= f;
        }
        WAVE_SYNC();
        const int khi = min(63, t - p0);
        for (int k = 0; k <= khi; ++k) {
            const float v = bf2f(Z[(size_t)(b * SEQ + p0 + k) * ZLD + vcol + lane]);
            o[0] += pl[k] * v; o[1] += pl[64 + k] * v; o[2] += pl[128 + k] * v; o[3] += pl[192 + k] * v;
        }
        WAVE_SYNC();
    }
#pragma unroll
    for (int r = 0; r < 4; ++r) {
        const float g1 = sigmoidf_(bf2f(zrow[ZC_NG + g * 12 + r * 3 + 1]));
        bf16_t* yp = Y + (size_t)bt * DM + 512 + g * 256 + r * 64 + lane;
        *yp = f2bf(bf2f(*yp) + g1 * o[r] / fmaxf(lsum[r], 1e-30f));
    }
    WAVE_SYNC();
}
namespace nsa {
typedef short bf16x8 __attribute__((ext_vector_type(8)));
typedef short s16x4 __attribute__((ext_vector_type(4)));
typedef float f32x16 __attribute__((ext_vector_type(16)));
typedef unsigned u32x4 __attribute__((ext_vector_type(4)));
#define NSA_LAS __attribute__((address_space(3)))
constexpr int KP = 72;
constexpr float LOG2E = 1.4426950408889634f, QSCALE = 0.125f * LOG2E, THR = 8.0f;
constexpr int TILE_B = 64 * KP * 2;
constexpr int BTP = 1040;
constexpr int OFF_BT = 0, OFF_K = 8 * BTP * 4, OFF_V = OFF_K + 2 * TILE_B, OFF_WS = OFF_V + 2 * TILE_B, WS_PER_WAVE = 256 + 8192, NSA_LDS = OFF_WS + 8 * WS_PER_WAVE;
static_assert(NSA_LDS <= LDS_BYTES, "nsa lds");
__device__ __forceinline__ int crow(int i, int h) { return (i & 3) + 8 * (i >> 2) + 4 * h; }
__device__ __forceinline__ float dpp_xor1(float v) { return __int_as_float(__builtin_amdgcn_update_dpp(0, __float_as_int(v), 0xB1, 0xF, 0xF, true)); }
__device__ __forceinline__ float dpp_xor2(float v) { return __int_as_float(__builtin_amdgcn_update_dpp(0, __float_as_int(v), 0x4E, 0xF, 0xF, true)); }
#define NSA_LWAIT() asm volatile("s_waitcnt lgkmcnt(0)" ::: "memory")
__device__ __forceinline__ float dpp_hmir(float v) { return __int_as_float(__builtin_amdgcn_update_dpp(0, __float_as_int(v), 0x141, 0xF, 0xF, true)); }
__device__ __forceinline__ int dppi_xor1(int v) { return __builtin_amdgcn_update_dpp(0, v, 0xB1, 0xF, 0xF, true); }
__device__ __forceinline__ int dppi_xor2(int v) { return __builtin_amdgcn_update_dpp(0, v, 0x4E, 0xF, 0xF, true); }
__device__ __forceinline__ int dppi_hmir(int v) { return __builtin_amdgcn_update_dpp(0, v, 0x141, 0xF, 0xF, true); }
__device__ __forceinline__ float swapadd(float v) {
    auto rr = __builtin_amdgcn_permlane32_swap(__float_as_uint(v), __float_as_uint(v), false, false);
    return __uint_as_float(rr[0]) + __uint_as_float(rr[1]);
}

__device__ __forceinline__ void fill_btab(const float* rel_bias, unsigned char* lds) {
    float* bt = (float*)(lds + OFF_BT);
    for (int i = tidx(); i < 8192; i += NT) { const int hh = i >> 10, d = i & 1023; bt[hh * BTP + d] = rel_bias[t5_bucket(d) * 8 + hh] * LOG2E; }
}
struct TileRegs { u32x4 k, v; };
__device__ __forceinline__ void tile_load(TileRegs& r, const bf16_t* kb, const bf16_t* vb, unsigned pitch, int r0) {
    const unsigned off = (unsigned)(r0 + (tidx() >> 3)) * pitch + (tidx() & 7) * 8;
    r.k = *(const u32x4*)(kb + off); r.v = *(const u32x4*)(vb + off);
}
__device__ __forceinline__ void tile_store(unsigned char* lds, int buf, const TileRegs& r) {
    const int o = ((tidx() >> 3) * KP + (tidx() & 7) * 8) * 2;
    *(u32x4*)(lds + OFF_K + buf * TILE_B + o) = r.k; *(u32x4*)(lds + OFF_V + buf * TILE_B + o) = r.v;
}
typedef NSA_LAS const unsigned char* ldsp;
__device__ __forceinline__ f32x16 qk32(ldsp Kl, const bf16x8 (&qf)[4], f32x16 c, int r32, int h) {
#pragma unroll
    for (int ks = 0; ks < 4; ++ks) {
        const bf16x8 kf = *(NSA_LAS const bf16x8*)(Kl + 32 * ks);
        c = __builtin_amdgcn_mfma_f32_32x32x16_bf16(kf, qf[ks], c, 0, 0, 0);
    }
    return c;
}
__device__ __forceinline__ s16x4 trread(ldsp p) { return __builtin_bit_cast(s16x4, __builtin_amdgcn_ds_read_tr16_b64_v4i16((NSA_LAS s16x4*)p)); }
__device__ __forceinline__ void pv32(f32x16 (&o)[2], ldsp Vl, const bf16x8 (&pf)[2], int lane) {
#pragma unroll
    for (int dt = 0; dt < 2; ++dt)
#pragma unroll
        for (int s = 0; s < 2; ++s) {
            ldsp a0 = Vl + (16 * s * KP + 32 * dt) * 2;
            const s16x4 lo = trread(a0), hi = trread(a0 + 8 * KP * 2);
            const bf16x8 vf = (bf16x8){lo[0], lo[1], lo[2], lo[3], hi[0], hi[1], hi[2], hi[3]};
            o[dt] = __builtin_amdgcn_mfma_f32_32x32x16_bf16(pf[s], vf, o[dt], 0, 0, 0);
        }
}
__device__ __forceinline__ void pack_p(const f32x16& s, bf16x8 (&pf)[2]) {
#pragma unroll
    for (int k = 0; k < 2; ++k) {
        u32x4 w; w.x = pg8::cvt_pk_bf16(s[8 * k + 0], s[8 * k + 1]); w.y = pg8::cvt_pk_bf16(s[8 * k + 2], s[8 * k + 3]); w.z = pg8::cvt_pk_bf16(s[8 * k + 4], s[8 * k + 5]); w.w = pg8::cvt_pk_bf16(s[8 * k + 6], s[8 * k + 7]);
        pf[k] = __builtin_bit_cast(bf16x8, w);
    }
}

__device__ __forceinline__ float swapmax(float v) {
    auto rr = __builtin_amdgcn_permlane32_swap(__float_as_uint(v), __float_as_uint(v), false, false);
    return fmaxf(__uint_as_float(rr[0]), __uint_as_float(rr[1]));
}
__device__ __forceinline__ float max16(const f32x16& s) {
    float a = __builtin_fmaxf(__builtin_fmaxf(s[0], s[1]), s[2]), b = __builtin_fmaxf(__builtin_fmaxf(s[3], s[4]), s[5]);
    a = __builtin_fmaxf(__builtin_fmaxf(a, s[6]), s[7]); b = __builtin_fmaxf(__builtin_fmaxf(b, s[8]), s[9]);
    a = __builtin_fmaxf(__builtin_fmaxf(a, s[10]), s[11]); b = __builtin_fmaxf(__builtin_fmaxf(b, s[12]), s[13]);
    a = __builtin_fmaxf(__builtin_fmaxf(a, s[14]), s[15]);
    return __builtin_fmaxf(a, b);
}
__device__ __forceinline__ void scale_rows(f32x16 (&o)[2], float f, float* wsf, int lane) {
    const int r32 = lane & 31, h = lane >> 5;
    if (h == 0) wsf[r32] = f;
    NSA_LWAIT();
#pragma unroll
    for (int i = 0; i < 16; ++i) { const float fi = wsf[crow(i, h)]; o[0][i] *= fi; o[1][i] *= fi; }
    NSA_LWAIT();
}
template <bool MASKED>
__device__ __forceinline__ void softmax_pv(f32x16 (&o)[2], float& m, float& lsum, f32x16& s, ldsp Vt, float* wsf, int lane) {
    float tmax = s[0];
#pragma unroll
    for (int i = 1; i < 16; ++i) tmax = fmaxf(tmax, s[i]);
    tmax = swapmax(tmax);
    if (__any(tmax > m + THR)) {
        const float mn = fmaxf(m, tmax), f = __builtin_amdgcn_exp2f(m - mn);
        lsum *= f; m = mn;
        scale_rows(o, f, wsf, lane);
    }
    float ps = 0.f;
#pragma unroll
    for (int i = 0; i < 16; ++i) { float pv = __builtin_amdgcn_exp2f(s[i] - m); if (MASKED) pv = s[i] > -1e29f ? pv : 0.f; s[i] = pv; ps += pv; }
    lsum += ps;
    bf16x8 pf[2]; pack_p(s, pf);
    pv32(o, Vt, pf, lane);
}

template <bool SEL>
__device__ __forceinline__ void softmax_pv2(f32x16 (&o)[2], float& m, float& lsum, f32x16& s0, f32x16& s1, ldsp Vt, float* wsf, int lane, bool lanesel) {
    float tmax = fmaxf(max16(s0), max16(s1));
    if (SEL) tmax = lanesel ? tmax : -1e30f;
    tmax = swapmax(tmax);
    if (__any(tmax > m + THR)) {
        const float mn = fmaxf(m, tmax), f = __builtin_amdgcn_exp2f(m - mn);
        lsum *= f; m = mn;
        scale_rows(o, f, wsf, lane);
    }
    const float mm = SEL ? (lanesel ? m : 1e30f) : m;
    float ps0 = 0.f, ps1 = 0.f;
#pragma unroll
    for (int i = 0; i < 16; ++i) { s0[i] = __builtin_amdgcn_exp2f(s0[i] - mm); ps0 += s0[i]; }
#pragma unroll
    for (int i = 0; i < 16; ++i) { s1[i] = __builtin_amdgcn_exp2f(s1[i] - mm); ps1 += s1[i]; }
    lsum += ps0 + ps1;
    bf16x8 pf0[2], pf1[2]; pack_p(s0, pf0); pack_p(s1, pf1);
    pv32(o, Vt, pf0, lane);
    pv32(o, Vt + 32 * KP * 2, pf1, lane);
}
__device__ __forceinline__ void load_q(bf16x8 (&qf)[4], const bf16_t* qp  ) {
#pragma unroll
    for (int ks = 0; ks < 4; ++ks) {
        const u32x4 w = *(const u32x4*)(qp + 16 * ks);
        const unsigned wv[4] = {w.x, w.y, w.z, w.w}; u32x4 o;
        unsigned ov[4];
#pragma unroll
        for (int j = 0; j < 4; ++j) ov[j] = pg8::cvt_pk_bf16(__uint_as_float(wv[j] << 16) * QSCALE, __uint_as_float(wv[j] & 0xffff0000u) * QSCALE);
        o.x = ov[0]; o.y = ov[1]; o.z = ov[2]; o.w = ov[3];
        qf[ks] = __builtin_bit_cast(bf16x8, o);
    }
}
__device__ __forceinline__ float gate_of(const bf16_t* zrow, int g, int hr, int br) { const float x = bf2f(zrow[ZC_NG + g * 12 + hr * 3 + br]); return 1.f / (1.f + __expf(-x)); }

__device__ __forceinline__ void softmax_rel(f32x16 (&o)[2], float& m, float& lsum, f32x16& s0, f32x16& s1, ldsp Vt, float* wsf, int lane) {
    const float tmax = swapmax(fmaxf(max16(s0), max16(s1)));
    if (__any(tmax > THR)) {
        const float d = fmaxf(tmax, 0.f), f = __builtin_amdgcn_exp2f(-d);
        m += d; lsum *= f;
        scale_rows(o, f, wsf, lane);
#pragma unroll
        for (int i = 0; i < 16; ++i) { s0[i] -= d; s1[i] -= d; }
    }
    float ps0 = 0.f, ps1 = 0.f;
#pragma unroll
    for (int i = 0; i < 16; ++i) { s0[i] = __builtin_amdgcn_exp2f(s0[i]); ps0 += s0[i]; }
#pragma unroll
    for (int i = 0; i < 16; ++i) { s1[i] = __builtin_amdgcn_exp2f(s1[i]); ps1 += s1[i]; }
    lsum += ps0 + ps1;
    bf16x8 pf0[2], pf1[2]; pack_p(s0, pf0); pack_p(s1, pf1);
    pv32(o, Vt, pf0, lane);
    pv32(o, Vt + 32 * KP * 2, pf1, lane);
}
__device__ __forceinline__ f32x16 splat16(float v) { return (f32x16){v, v, v, v, v, v, v, v, v, v, v, v, v, v, v, v}; }
__device__ __forceinline__ void softmax_rel1(f32x16 (&o)[2], float& m, float& lsum, f32x16& s0, ldsp Vt, float* wsf, int lane) {
    const float tmax = swapmax(max16(s0));
    if (__any(tmax > THR)) {
        const float d = fmaxf(tmax, 0.f), f = __builtin_amdgcn_exp2f(-d);
        m += d; lsum *= f;
        scale_rows(o, f, wsf, lane);
#pragma unroll
        for (int i = 0; i < 16; ++i) s0[i] -= d;
    }
    float ps0 = 0.f;
#pragma unroll
    for (int i = 0; i < 16; ++i) { s0[i] = __builtin_amdgcn_exp2f(s0[i]); ps0 += s0[i]; }
    lsum += ps0;
    bf16x8 pf0[2]; pack_p(s0, pf0);
    pv32(o, Vt, pf0, lane);
}
__device__ __forceinline__ void cmpwin_item(const bf16_t* Z, const bf16_t* KCb, const bf16_t* VCb, unsigned* SELMASK, bf16_t* Y, unsigned char* lds, int bg, int qt) {
    const int tid = tidx(), lane = tid & 63, wave = tid >> 6, r32 = lane & 31, h = lane >> 5;
    const int b_ = bg >> 1, g = bg & 1, tl = r32 >> 2, hr = r32 & 3;
    const int t = 64 * qt + 8 * wave + tl;
    const unsigned tok = (unsigned)(b_ * SEQ + t);
    const float* bt = (const float*)(lds + OFF_BT) + (g * 4 + hr) * BTP;
    float* wsf = (float*)(lds + OFF_WS + wave * WS_PER_WAVE);
    float* pmain = wsf + 64; float* pspill = pmain + 1024;
    const ldsp KL = (ldsp)lds + OFF_K + (r32 * KP + 8 * h) * 2;
    const ldsp VL = (ldsp)lds + OFF_V + ((4 * h + ((lane & 15) >> 2)) * KP + 16 * ((lane >> 4) & 1) + 4 * (lane & 3)) * 2;
    bf16x8 qf[4]; load_q(qf, Z + (tok * ZLD + ZC_NQ + g * 256 + hr * 64 + 8 * h));
    const f32x16 zero16 = (f32x16){0, 0, 0, 0, 0, 0, 0, 0, 0, 0, 0, 0, 0, 0, 0, 0};
    TileRegs tr;
    int buf = 0;
    const int cmax = min(4 * qt + 2, 510), nct = cmax / 64 + 1;
    const int cv = t >= 31 ? ((t - 31) >> 4) : -1;
    const bf16_t* kc = KCb + (unsigned)(bg * 512 * 64); const bf16_t* vc = VCb + (unsigned)(bg * 512 * 64);
    const bool dosel = qt >= 16;
    float m = -1e30f, l = 0.f;
    const float bfar = bt[1023];
    const int tmin = 64 * qt + 8 * wave;
    const int cvmin = tmin >= 31 ? ((tmin - 31) >> 4) : -1;
#define CMP_FAST(cbase) (((cbase) + 31 <= cvmin) && (tmin - 31 - 16 * ((cbase) + 31) >= 790))
    tile_load(tr, kc, vc, 64, 0);
    for (int j = 0; j < nct; ++j) {
        tile_store(lds, buf, tr); __syncthreads();
        if (j + 1 < nct) tile_load(tr, kc, vc, 64, 64 * (j + 1));
#pragma unroll
        for (int sub = 0; sub < 2; ++sub) {
            const int cbase = 64 * j + 32 * sub;
            if (cbase <= cmax) {
                const bool fast = CMP_FAST(cbase);
                f32x16 s = qk32(KL + buf * TILE_B + sub * 32 * KP * 2, qf, splat16(fast ? bfar : 0.f), r32, h);
                if (!fast) {
                    const int db = t - 31 - 16 * (cbase + 4 * h);
#pragma unroll
                    for (int i = 0; i < 16; ++i) {
                        const int co = (i & 3) + 8 * (i >> 2);
                        const float v = s[i] + bt[min((unsigned)(db - 16 * co), 1023u)];
                        s[i] = (cbase + 4 * h + co <= cv) ? v : -1e30f;
                    }
                }
                const float mn = fmaxf(m, swapmax(max16(s)));
                float ps = 0.f;
#pragma unroll
                for (int i = 0; i < 16; ++i) ps += __builtin_amdgcn_exp2f(s[i] - mn);
                l = (mn > -1e29f) ? l * __builtin_amdgcn_exp2f(m - mn) + ps : 0.f; m = mn;
            }
        }
        buf ^= 1;
    }
    l = swapadd(l);
    const float cb = (l > 0.f) ? -m - __builtin_amdgcn_logf(l) : 0.f;
    f32x16 oc[2] = {zero16, zero16};
    __syncthreads();
    tile_load(tr, kc, vc, 64, 0);
    for (int j = 0; j < nct; ++j) {
        tile_store(lds, buf, tr); __syncthreads();
        if (j + 1 < nct) tile_load(tr, kc, vc, 64, 64 * (j + 1));
#pragma unroll
        for (int sub = 0; sub < 2; ++sub) {
            const int cbase = 64 * j + 32 * sub;
            if (cbase <= cmax) {
                const bool fast = CMP_FAST(cbase);
                f32x16 s = qk32(KL + buf * TILE_B + sub * 32 * KP * 2, qf, splat16(fast ? bfar + cb : cb), r32, h);
                if (fast) {
#pragma unroll
                    for (int i = 0; i < 16; ++i) s[i] = __builtin_amdgcn_exp2f(s[i]);
                } else {
                    const int db = t - 31 - 16 * (cbase + 4 * h);
#pragma unroll
                    for (int i = 0; i < 16; ++i) {
                        const int co = (i & 3) + 8 * (i >> 2);
                        const float v = s[i] + bt[min((unsigned)(db - 16 * co), 1023u)];
                        s[i] = (cbase + 4 * h + co <= cv) ? __builtin_amdgcn_exp2f(v) : 0.f;
                    }
                }
                if (dosel) {
#pragma unroll
                    for (int q = 0; q < 4; ++q) {
                        float mainv = 2.f * (s[4 * q] + s[4 * q + 1] + s[4 * q + 2]) + s[4 * q + 3], spv = s[4 * q + 3];
                        mainv += dpp_xor1(mainv); mainv += dpp_xor2(mainv); spv += dpp_xor1(spv); spv += dpp_xor2(spv);
                        if (hr == 0) {
                            const int jb = (cbase >> 2) + 2 * q + h;
                            pmain[tl * 128 + jb] = mainv;
                            if (jb + 1 < 128) pspill[tl * 128 + jb + 1] = spv;
                        }
                    }
                }
                bf16x8 pf[2]; pack_p(s, pf);
                pv32(oc, VL + buf * TILE_B + sub * 32 * KP * 2, pf, lane);
            }
        }
        buf ^= 1;
    }
#undef CMP_FAST
    NSA_LWAIT();
    {
        const int stok = lane >> 3, si = lane & 7;
        unsigned mybits = 0u;
        if (dosel) {
            float vals[16];
#pragma unroll
            for (int k = 0; k < 16; ++k) { const int jb = si + 8 * k; vals[k] = (jb >= 1 && jb <= qt - 2) ? pmain[stok * 128 + jb] + pspill[stok * 128 + jb] : -1.f; }
            for (int it = 0; it < 13; ++it) {
                float bv = -2.f; int bk = 0;
#pragma unroll
                for (int k = 0; k < 16; ++k) if (vals[k] > bv) { bv = vals[k]; bk = k; }
                int bj = si + 8 * bk;
                { float ov = dpp_xor1(bv); int oj = dppi_xor1(bj); if (ov > bv || (ov == bv && oj < bj)) { bv = ov; bj = oj; }
                  ov = dpp_xor2(bv); oj = dppi_xor2(bj); if (ov > bv || (ov == bv && oj < bj)) { bv = ov; bj = oj; }
                  ov = dpp_hmir(bv); oj = dppi_hmir(bj); if (ov > bv || (ov == bv && oj < bj)) { bv = ov; bj = oj; } }
                const bool mine = (bj & 7) == si; const int wk = bj >> 3;
#pragma unroll
                for (int k = 0; k < 16; ++k) if (mine && k == wk) vals[k] = -3.f;
                if (mine) mybits |= 1u << wk;
            }
            if (si == 0) mybits |= 1u;
            if (((qt - 1) & 7) == si) mybits |= 1u << ((qt - 1) >> 3);
            if ((qt & 7) == si) mybits |= 1u << (qt >> 3);
        } else {
#pragma unroll
            for (int k = 0; k < 16; ++k) if (si + 8 * k <= qt) mybits |= 1u << k;
        }
        unsigned wd[4];
#pragma unroll
        for (int w = 0; w < 4; ++w) {
            unsigned x = 0u;
#pragma unroll
            for (int kk = 0; kk < 4; ++kk) if ((mybits >> (4 * w + kk)) & 1u) x |= 1u << (si + 8 * kk);
            x |= (unsigned)dppi_xor1((int)x); x |= (unsigned)dppi_xor2((int)x); x |= (unsigned)dppi_hmir((int)x);
            wd[w] = x;
        }
        if (si == 0) *(u32x4*)(SELMASK + (unsigned)((bg * SEQ + 64 * qt + 8 * wave + stok) * 4)) = (u32x4){wd[0], wd[1], wd[2], wd[3]};
    }
    { const int l2 = tidx() & 63, r2 = l2 & 31; const unsigned tk = (unsigned)(b_ * SEQ + 64 * qt + 8 * (tidx() >> 6) + (r2 >> 2)); scale_rows(oc, gate_of(Z + tk * ZLD, g, r2 & 3, 0), wsf, lane); }
    const unsigned yo = (unsigned)((b_ * SEQ + 64 * qt + 8 * wave + h) * DM + 512 + g * 256 + r32);
#pragma unroll
    for (int i = 0; i < 16; ++i) {
        const int ci = (i & 3) + 8 * (i >> 2);
        const unsigned o = yo + (unsigned)((ci >> 2) * DM + (ci & 3) * 64);
        Y[o] = f2bf(oc[0][i]); Y[o + 32] = f2bf(oc[1][i]);
    }
    f32x16 ow[2] = {zero16, zero16};
    m = 0.f; l = 0.f;
    const bf16_t* kw = Z + (unsigned)(b_ * SEQ * ZLD + ZC_NKV + 4 * 128 + g * 64); const bf16_t* vw = kw + 128;
    const int j0 = qt >= 8 ? qt - 8 : 0;
    __syncthreads();
    tile_load(tr, kw, vw, ZLD, 64 * j0);
    for (int j = j0; j <= qt; ++j) {
        tile_store(lds, buf, tr); __syncthreads();
        if (j < qt) tile_load(tr, kw, vw, ZLD, 64 * (j + 1));
        const bool edge = (j == qt) || (j == qt - 8);
        const f32x16 ci = splat16(-m);
        if (edge) {
#pragma unroll
            for (int sub = 0; sub < 2; ++sub) {
                const int kb = 64 * j + 32 * sub;
                if (kb > 64 * qt + 8 * wave + 7) continue;
                if (kb + 31 + 512 <= 64 * qt + 8 * wave) continue;
                f32x16 s = qk32(KL + buf * TILE_B + sub * 32 * KP * 2, qf, splat16(-m), r32, h);
                const int db = t - kb - 4 * h;
#pragma unroll
                for (int i = 0; i < 16; ++i) { const int dist = db - ((i & 3) + 8 * (i >> 2)); const float v = s[i] + bt[min((unsigned)dist, 1023u)]; s[i] = (dist >= 0 && dist < 512) ? v : -1e30f; }
                softmax_rel1(ow, m, l, s, VL + buf * TILE_B + sub * 32 * KP * 2, wsf, lane);
            }
        } else {
            f32x16 s0 = qk32(KL + buf * TILE_B, qf, ci, r32, h), s1 = qk32(KL + buf * TILE_B + 32 * KP * 2, qf, ci, r32, h);
            const int db = t - 64 * j - 4 * h;
#pragma unroll
            for (int i = 0; i < 16; ++i) { const int co = (i & 3) + 8 * (i >> 2); s0[i] += bt[db - co]; s1[i] += bt[db - 32 - co]; }
            softmax_rel(ow, m, l, s0, s1, VL + buf * TILE_B, wsf, lane);
        }
        buf ^= 1;
    }
    l = swapadd(l);
    { const int l2 = tidx() & 63, r2 = l2 & 31; const unsigned tk = (unsigned)(b_ * SEQ + 64 * qt + 8 * (tidx() >> 6) + (r2 >> 2)); scale_rows(ow, gate_of(Z + tk * ZLD, g, r2 & 3, 2) / fmaxf(l, 1e-30f), wsf, lane); }
#pragma unroll
    for (int i = 0; i < 16; ++i) {
        const int ci = (i & 3) + 8 * (i >> 2);
        const unsigned o = yo + (unsigned)((ci >> 2) * DM + (ci & 3) * 64);
        Y[o] = f2bf(bf2f(Y[o]) + ow[0][i]); Y[o + 32] = f2bf(bf2f(Y[o + 32]) + ow[1][i]);
    }
    __syncthreads();
}
constexpr int S2_TILE = 128 * KP * 2;
constexpr int S2_K = OFF_K, S2_V = S2_K + 2 * S2_TILE, S2_WS = S2_V + 2 * S2_TILE;
static_assert(S2_WS + 8 * 256 <= LDS_BYTES - 64, "slc lds");
struct TileRegs2 { u32x4 k0, k1, v0, v1; };
__device__ __forceinline__ void tile_load2(TileRegs2& r, const bf16_t* kb, const bf16_t* vb, int r0, int rmax) {
    const int ra = min(r0 + (tidx() >> 3), rmax), rb = min(r0 + 64 + (tidx() >> 3), rmax);
    const unsigned oa = (unsigned)ra * ZLD + (tidx() & 7) * 8, ob = (unsigned)rb * ZLD + (tidx() & 7) * 8;
    r.k0 = *(const u32x4*)(kb + oa); r.v0 = *(const u32x4*)(vb + oa); r.k1 = *(const u32x4*)(kb + ob); r.v1 = *(const u32x4*)(vb + ob);
}
__device__ __forceinline__ void tile_store2(unsigned char* lds, int buf, const TileRegs2& r) {
    const int o = ((tidx() >> 3) * KP + (tidx() & 7) * 8) * 2;
    *(u32x4*)(lds + S2_K + buf * S2_TILE + o) = r.k0; *(u32x4*)(lds + S2_K + buf * S2_TILE + 64 * KP * 2 + o) = r.k1;
    *(u32x4*)(lds + S2_V + buf * S2_TILE + o) = r.v0; *(u32x4*)(lds + S2_V + buf * S2_TILE + 64 * KP * 2 + o) = r.v1;
}
__device__ __forceinline__ void slc_item(const bf16_t* Z, const unsigned* SELMASK, bf16_t* Y, unsigned char* lds, int bg, int qt, float dsc) {
    const int tid = tidx(), lane = tid & 63, wave = tid >> 6, r32 = lane & 31, h = lane >> 5;
    const int b_ = bg >> 1, g = bg & 1, tl = r32 >> 2, hr = r32 & 3;
    const int t = 64 * qt + 8 * wave + tl;
    const unsigned tok = (unsigned)(b_ * SEQ + t);
    const float* bt = (const float*)(lds + OFF_BT) + (g * 4 + hr) * BTP;
    float* wsf = (float*)(lds + S2_WS + wave * 256);
    const ldsp KL = (ldsp)lds + S2_K + (r32 * KP + 8 * h) * 2;
    const ldsp VL = (ldsp)lds + S2_V + ((4 * h + ((lane & 15) >> 2)) * KP + 16 * ((lane >> 4) & 1) + 4 * (lane & 3)) * 2;
    bf16x8 qf[4]; load_q(qf, Z + (tok * ZLD + ZC_NQ + g * 256 + hr * 64 + 8 * h));
    const u32x4 mk = *(const u32x4*)(SELMASK + (unsigned)((bg * SEQ + t) * 4));
    const float bfar = bt[1023];
    f32x16 o[2] = {splat16(0.f), splat16(0.f)};
    float m = 0.f, l = 0.f;
    const bf16_t* ksl = Z + (unsigned)(b_ * SEQ * ZLD + ZC_NKV + 2 * 128 + g * 64); const bf16_t* vsl = ksl + 128;
    const int rmax = 64 * qt + 63, nstep = (qt >> 1) + 1;
    TileRegs2 tr; int buf = 0;
    tile_load2(tr, ksl, vsl, 0, rmax);
    for (int st = 0; st < nstep; ++st) {
        tile_store2(lds, buf, tr); __syncthreads();
        if (st + 1 < nstep) tile_load2(tr, ksl, vsl, 128 * (st + 1), rmax);
#pragma unroll
        for (int hb = 0; hb < 2; ++hb) {
            const int j = 2 * st + hb;
            if (j > qt) break;
            const int jw = j >> 5;
            const unsigned mw = jw == 0 ? mk.x : (jw == 1 ? mk.y : (jw == 2 ? mk.z : mk.w));
            const bool sel = (mw >> (j & 31)) & 1u;
            if (!__any(sel)) continue;
            const ldsp Kt = KL + buf * S2_TILE + hb * 64 * KP * 2;
            const ldsp Vt = VL + buf * S2_TILE + hb * 64 * KP * 2;
            const bool near = (qt - j) < 14;
            const f32x16 ci = splat16(sel ? (near ? 0.f : bfar) - m : -1e30f);
            f32x16 s0 = qk32(Kt, qf, ci, r32, h), s1 = qk32(Kt + 32 * KP * 2, qf, ci, r32, h);
            if (near) {
                const int db = t - 64 * j - 4 * h;
                if (j == qt) {
#pragma unroll
                    for (int i = 0; i < 16; ++i) { const int co = (i & 3) + 8 * (i >> 2); const int d0 = db - co, d1 = db - 32 - co;
                        s0[i] = d0 >= 0 ? s0[i] + bt[min((unsigned)d0, 1023u)] : -1e30f; s1[i] = d1 >= 0 ? s1[i] + bt[min((unsigned)d1, 1023u)] : -1e30f; }
                } else {
#pragma unroll
                    for (int i = 0; i < 16; ++i) { const int co = (i & 3) + 8 * (i >> 2); s0[i] += bt[min(db - co, 1023)]; s1[i] += bt[min(db - 32 - co, 1023)]; }
                }
            }
            softmax_rel(o, m, l, s0, s1, Vt, wsf, lane);
        }
        buf ^= 1;
    }
    l = swapadd(l);
    scale_rows(o, dsc * gate_of(Z + tok * ZLD, g, hr, 1) / fmaxf(l, 1e-30f), wsf, lane);
    const unsigned yo = (unsigned)((b_ * SEQ + 64 * qt + 8 * wave + h) * DM + 512 + g * 256 + r32);
#pragma unroll
    for (int i = 0; i < 16; ++i) {
        const int ci = (i & 3) + 8 * (i >> 2);
        const unsigned oo = yo + (unsigned)((ci >> 2) * DM + (ci & 3) * 64);
        Y[oo] = f2bf(bf2f(Y[oo]) + o[0][i]); Y[oo + 32] = f2bf(bf2f(Y[oo + 32]) + o[1][i]);
    }
    __syncthreads();
}
}


namespace cmpr {
typedef short bf16x8 __attribute__((ext_vector_type(8)));
constexpr int OFF_PART = 0, OFF_HID = 32768, CMPR_LDS = OFF_HID + 16 * 72 * 2;
__device__ __forceinline__ void item(const bf16_t* Z, const bf16_t* W1t, const bf16_t* W2t, const float* posb, bf16_t* OUT, unsigned char* lds, int bg, int kv, int nt) {
    const int tid = tidx(), lane = tid & 63, wave = tid >> 6, row = lane & 15, kq = lane >> 4;
    const int b_ = bg >> 1, g = bg & 1, n = 16 * nt + row;
    f32x4 acc[4];
#pragma unroll
    for (int mt = 0; mt < 4; ++mt) acc[mt] = (f32x4){0.f, 0.f, 0.f, 0.f};
    const unsigned zbase = (unsigned)(b_ * SEQ * ZLD + ZC_NKV + kv * 128 + g * 64 + 8 * kq);
#pragma unroll
    for (int kk = 0; kk < 8; ++kk) {
        const int ks = 8 * wave + kk;
        const int tok = min(16 * n + (ks >> 1), SEQ - 1);
        const bf16x8 a = *(const bf16x8*)(Z + (zbase + (unsigned)(tok * ZLD + 32 * (ks & 1))));
#pragma unroll
        for (int mt = 0; mt < 4; ++mt) {
            const bf16x8 bq = *(const bf16x8*)(W1t + (unsigned)((16 * mt + row) * 2048 + 32 * ks + 8 * kq));
            acc[mt] = __builtin_amdgcn_mfma_f32_16x16x32_bf16(a, bq, acc[mt], 0, 0, 0);
        }
    }
    float* part = (float*)(lds + OFF_PART) + wave * 1024;
#pragma unroll
    for (int mt = 0; mt < 4; ++mt)
#pragma unroll
        for (int r = 0; r < 4; ++r) part[(4 * kq + r) * 64 + 16 * mt + row] = acc[mt][r];
    __syncthreads();
    bf16_t* hid = (bf16_t*)(lds + OFF_HID);
    {
        const int nn = tid >> 5, m2 = (tid & 31) * 2;
        float s0 = 0.f, s1 = 0.f;
#pragma unroll
        for (int w = 0; w < 8; ++w) { const float2 v = *(const float2*)((const float*)(lds + OFF_PART) + w * 1024 + nn * 64 + m2); s0 += v.x; s1 += v.y; }
        *(unsigned*)(hid + nn * 72 + m2) = pg8::cvt_pk_bf16(gelu_tanh(s0 + posb[m2]), gelu_tanh(s1 + posb[m2 + 1]));
    }
    __syncthreads();
    if (wave < 4) {
        const int et = wave;
        f32x4 o = (f32x4){0.f, 0.f, 0.f, 0.f};
#pragma unroll
        for (int ks = 0; ks < 2; ++ks) {
            const bf16x8 a = *(const bf16x8*)(lds + OFF_HID + (row * 72 + 32 * ks + 8 * kq) * 2);
            const bf16x8 bq = *(const bf16x8*)(W2t + (16 * et + row) * 64 + 32 * ks + 8 * kq);
            o = __builtin_amdgcn_mfma_f32_16x16x32_bf16(a, bq, o, 0, 0, 0);
        }
#pragma unroll
        for (int r = 0; r < 4; ++r) { const int nn = 16 * nt + 4 * kq + r; OUT[(unsigned)((bg * 512 + nn) * 64 + 16 * et + row)] = (nn < NCMP) ? f2bf(o[r]) : (bf16_t)0; }
    }
    __syncthreads();
}
}
#define LAS __attribute__((address_space(3)))
#define XB_TMO      128
#define XB_XCNT(j)  (256  + 64 * (j))
#define XB_XSUB(j)  (1280 + 64 * (j))
#define XB_XGEN(j)  (2304 + 64 * (j))
#define XB_TOP      3328
#define XB_TOPGEN   3392
#define XCD_BAR_WORDS 3456
#define XB_SPIN_CAP (1u << 18)

__device__ __forceinline__ unsigned xb_ld(unsigned* p)              { return __hip_atomic_load(p, __ATOMIC_RELAXED, __HIP_MEMORY_SCOPE_AGENT); }
__device__ __forceinline__ unsigned xb_add(unsigned* p, unsigned v) { return __hip_atomic_fetch_add(p, v, __ATOMIC_RELAXED, __HIP_MEMORY_SCOPE_AGENT); }
__device__ __forceinline__ unsigned xb_xcc_id() { return (unsigned)__builtin_amdgcn_s_getreg((3 << 11) | 20) & 0xFu; }
#define XB_SPIN(cond, bar) do { unsigned _sp = 0; while (cond) { __builtin_amdgcn_s_sleep(1); \
    if ((++_sp & 255u) == 0u) { if (xb_ld(&(bar)[XB_TMO])) break; if (_sp > XB_SPIN_CAP) { atomicAdd(&(bar)[XB_TMO], 1u); break; } } } } while (0)

struct XcdBarrier {
    unsigned* bar; unsigned x;
    volatile LAS unsigned* st;
};

__device__ __forceinline__ XcdBarrier xcd_barrier_post(unsigned* bar, volatile LAS unsigned* st) {
    XcdBarrier b; b.bar = bar; b.x = xb_xcc_id(); b.st = st;
    if (threadIdx.x == 0) (void)xb_add(&bar[XB_XCNT(b.x)], 1u);
    return b;
}
__device__ __forceinline__ void xcd_barrier_complete(unsigned* bar, unsigned x, unsigned& nloc, unsigned& nx) {
    const unsigned G = gridDim.x * gridDim.y * gridDim.z;
    unsigned sum, cnt, mine, sp = 0u;
    for (;;) {
        sum = 0u; cnt = 0u; mine = 0u;
#pragma unroll
        for (unsigned j = 0; j < 16; ++j) { const unsigned c = xb_ld(&bar[XB_XCNT(j)]); sum += c; cnt += (c > 0u) ? 1u : 0u; mine = (j == x) ? c : mine; }
        if (sum == G) break;
        __builtin_amdgcn_s_sleep(1);
        if ((++sp & 255u) == 0u) { if (xb_ld(&bar[XB_TMO])) break; if (sp > XB_SPIN_CAP) { atomicAdd(&bar[XB_TMO], 1u); break; } }
    }
    nloc = mine > 0u ? mine : 1u; nx = cnt > 0u ? cnt : 1u;
}

__device__ __forceinline__ void xcd_barrier(const XcdBarrier& b) {
    asm volatile("s_waitcnt vmcnt(0)" ::: "memory");
    __syncthreads();
    if (threadIdx.x == 0) {
        unsigned* bar = b.bar;
        __builtin_amdgcn_s_waitcnt(0);
        unsigned nloc = b.st[0], nx = b.st[1];
        if (nloc == 0u) { xcd_barrier_complete(bar, b.x, nloc, nx); b.st[0] = nloc; b.st[1] = nx; }
        const unsigned old = xb_add(&bar[XB_XSUB(b.x)], 1u);
        const unsigned gen = old / nloc;
        if (old + 1u == (gen + 1u) * nloc) {
            __builtin_amdgcn_fence(__ATOMIC_RELEASE, "agent");
            asm volatile("s_waitcnt vmcnt(0)" ::: "memory");
            const unsigned og = xb_add(&bar[XB_TOP], 1u);
            const unsigned tg = og / nx;
            if (og + 1u == (tg + 1u) * nx) xb_add(&bar[XB_TOPGEN], 1u);
            else XB_SPIN(xb_ld(&bar[XB_TOPGEN]) == tg, bar);
            __builtin_amdgcn_fence(__ATOMIC_ACQUIRE, "agent");
            xb_add(&bar[XB_XGEN(b.x)], 1u);
            asm volatile("s_waitcnt vmcnt(0)" ::: "memory");
        } else {
            XB_SPIN(xb_ld(&bar[XB_XGEN(b.x)]) == gen, bar);
            __builtin_amdgcn_fence(__ATOMIC_ACQUIRE, "agent");
            asm volatile("s_waitcnt vmcnt(0)" ::: "memory");
        }
    }
    __syncthreads();
}

template <int L, int WHICH>
__device__ __forceinline__ void convert_group(const Params& p, float* lds, int wrank, int nwaves) {
    unsigned char* wl = p.ws + WS_W + L * W_LAYER;
    int cwg = wrank; const int NGW = nwaves;
    if constexpr (WHICH == 0) {
        convert_wt(p.in[2] + (size_t)L * DM * DFF, DM, DFF, p.in[1] + L * DM, (bf16_t*)(wl + W_GU1), 2, 0, lds, cwg, NGW);
        convert_wt(p.in[3] + (size_t)L * DM * DFF, DM, DFF, p.in[1] + L * DM, (bf16_t*)(wl + W_GU1), 2, 1, lds, cwg, NGW);
        convert_wt(p.in[4] + (size_t)L * DM * DFF, DFF, DM, nullptr, (bf16_t*)(wl + W_D1), 1, 0, lds, cwg, NGW);
    } else {
        convert_wt(p.in[6] + (size_t)L * DM * DIN, DM, DIN, p.in[5] + L * DM, (bf16_t*)(wl + W_IN), 1, 0, lds, cwg, NGW);
        convert_wt(p.in[7] + (size_t)L * DM * DM, DM, DM, nullptr, (bf16_t*)(wl + W_OUT), 1, 0, lds, cwg, NGW);
        convert_wt(p.in[27] + (size_t)L * DM * DFF, DM, DFF, p.in[26] + L * DM, (bf16_t*)(wl + W_GU2), 2, 0, lds, cwg, NGW);
        convert_wt(p.in[28] + (size_t)L * DM * DFF, DM, DFF, p.in[26] + L * DM, (bf16_t*)(wl + W_GU2), 2, 1, lds, cwg, NGW);
        convert_wt(p.in[29] + (size_t)L * DM * DFF, DFF, DM, nullptr, (bf16_t*)(wl + W_D2), 1, 0, lds, cwg, NGW);
        bf16_t* win = (bf16_t*)(wl + W_IN);
        for (int i = wrank * 64 + (tidx() & 63); i < (ZLD - DIN) * DM; i += nwaves * 64) win[DIN * DM + i] = 0;
    }
}

constexpr int ST_PER_LAYER = 10, NSTAGES = 1 + 2 * ST_PER_LAYER + 1;

template <class Epi, bool LDAK = true>
__device__ __forceinline__ void gemm_stage(float* lds, const bf16_t* A, const bf16_t* Bt, int N, int K, const Epi& E, int lda = 0) {
    pg8::Gemm g{A, Bt, MTOK, N, K, lda ? lda : K};
    pg8::StaticOrder S; S.init(MTOK, N, (int)gridDim.x, (int)blockIdx.x);
    pg8::gemm_phase<Epi, pg8::StaticOrder, true, true, LDAK>((PG8_LAS unsigned char*)lds, g, S, E);
}

template <int st>
__device__ __forceinline__ void run_stage(const Params& p, float* lds, float dsc = 1.0f) {
    const int bid = blockIdx.x, nb = gridDim.x, tid = tidx(), wave = tid >> 6;
    unsigned char* ws = p.ws;
    float* SSQ = (float*)(ws + WS_SMALL + SM_SSQ);
    float* LB = (float*)(ws + WS_SMALL + SM_LB);
    bf16_t* KC = (bf16_t*)(ws + WS_SMALL + SM_KC);
    bf16_t* VC = (bf16_t*)(ws + WS_SMALL + SM_VC);
    bf16_t* XB = (bf16_t*)(ws + WS_XB);
    unsigned char* msc = (unsigned char*)p.X;
    bf16_t* HZ = (bf16_t*)(ws + WS_HZ);
    bf16_t* Y = (bf16_t*)(ws + WS_Y);
    if constexpr (st == 0) {
        const int NGW = nb * NWAVE; int cwg = bid * NWAVE + wave;
        convert_group<0, 0>(p, lds, cwg, NGW);
        cwg = bid * NWAVE + wave;
        for (int l = 0; l < 2; ++l) {
            s5_tables(p, l, (float*)(ws + WS_SMALL + SM_S5AB + l * SM_S5_LAYER), bid * NT + tid, nb * NT);
            convert_wt(p.in[16] + (size_t)l * 65536, 256, 256, nullptr, (bf16_t*)(ws + WS_SMALL + SM_WGLU) + l * 65536, 1, 0, lds, cwg, NGW);
            for (int kv = 0; kv < 2; ++kv) {
                convert_wt(p.in[kv ? 23 : 20] + (size_t)l * 131072, 2048, 64, nullptr, (bf16_t*)(ws + WS_SMALL + SM_W1T) + (l * 2 + kv) * 131072, 1, 0, lds, cwg, NGW);
                convert_wt(p.in[kv ? 24 : 21] + (size_t)l * 4096, 64, 64, nullptr, (bf16_t*)(ws + WS_SMALL + SM_W2T) + (l * 2 + kv) * 4096, 1, 0, lds, cwg, NGW);
            }
            for (int i = bid * NWAVE + wave; i < 128; i += nb * NWAVE) {
                const int kv = i >> 6, m = i & 63, ln = tid & 63; const float* pos = p.in[kv ? 22 : 19] + l * 2048; const float* w1 = p.in[kv ? 23 : 20] + (size_t)l * 131072;
                float a = 0.f;
#pragma unroll 8
                for (int q = ln; q < 2048; q += 64) a += pos[q] * w1[(size_t)q * 64 + m];
                a = wave_sum(a);
                if (ln == 0) ((float*)(ws + WS_SMALL + SM_POSB))[(l * 2 + kv) * 64 + m] = a;
            }
        }
        s5::pow_table(p, (float*)(ws + WS_POW), bid * NT + tid, nb * NT);
        for (int i = bid * NT + tid; i < 256; i += nb * NT) {
            const float a = p.in[17][i], bq = p.in[17][256 + i], mx = fmaxf(a, bq);
            const float ea = expf(a - mx), eb = expf(bq - mx);
            LB[i] = 0.f; LB[256 + i] = eb / (ea + eb);
        }
        rowstats(p.in[0], const_cast<float*>(p.in[0]), XB, SSQ, bid, nb);
        __syncthreads();
        return;
    }
    if constexpr (st == NSTAGES - 1) { final_norm(p.X, SSQ, p.in[30], bid, nb); return; }
    constexpr int l = (st - 1) / ST_PER_LAYER, s = (st - 1) % ST_PER_LAYER;
    unsigned char* wl = ws + WS_W + l * W_LAYER;
    if constexpr (s == 0) {
        if constexpr (l == 0) {
            for (int ll = 0; ll < 2; ++ll) {
                s5::build_tables(p, ll, (const float*)(ws + WS_POW), (const float*)(ws + WS_SMALL + SM_S5AB + ll * SM_S5_LAYER), ws + WS_S5T + (size_t)ll * s5::T_LAYER, bid * NT + tid, nb * NT);
                for (int i = bid * NT + tid; i < 1024; i += nb * NT) { const float* pw = (const float*)(ws + WS_POW) + ((size_t)((ll * 16 + (i >> 6)) * 65 + 64) * 64 + (i & 63)) * 2; float* a64 = (float*)(ws + WS_SMALL + SM_A64) + (ll * 1024 + i) * 2; a64[0] = pw[0]; a64[1] = pw[1]; }
            }
        }
        gemm_stage(lds, XB, (const bf16_t*)(wl + W_GU1), 2 * DFF, DM, pg8::EpiGU{SSQ, HZ, DFF});
        if constexpr (l == 0) { if (nb == 256 && bid >= 128) convert_group<0, 1>(p, lds, (bid - 128) * NWAVE + wave, 128 * NWAVE); else if (nb != 256) convert_group<0, 1>(p, lds, bid * NWAVE + wave, nb * NWAVE); }
    }
    if constexpr (s == 1) gemm_stage(lds, HZ, (const bf16_t*)(wl + W_D1), DM, DFF, pg8::EpiResB<(l == 0), false>{p.in[0], p.X, XB, SSQ, 0.5f * dsc});
    if constexpr (s == 2) {
        gemm_stage(lds, XB, (const bf16_t*)(wl + W_IN), ZLD, DM, pg8::EpiZ{SSQ, HZ, ZLD});
        if constexpr (l == 0) { if (nb == 256 && bid >= 192) convert_group<1, 0>(p, lds, (bid - 192) * NWAVE + wave, 64 * NWAVE); else if (nb != 256) convert_group<1, 0>(p, lds, bid * NWAVE + wave, nb * NWAVE); }
    }
    if constexpr (s == 3) {
        for (int item = bid; item < 256; item += nb) s5::phase1(HZ, ws + WS_S5T + (size_t)l * s5::T_LAYER, (float*)(msc + WS_S5_XE), (unsigned char*)lds, item);
        for (int item = bid; item < 1024; item += nb) hg::phase1(HZ, LB + l * 256, (float*)(msc + WS_HG_DS), (float*)(msc + WS_HG_GAM), (unsigned char*)lds, item);
        for (int item = bid; item < 256; item += nb) {
            const int nt = item & 31, kv = (item >> 5) & 1, bg = item >> 6;
            cmpr::item(HZ, (const bf16_t*)(ws + WS_SMALL + SM_W1T) + (l * 2 + kv) * 131072, (const bf16_t*)(ws + WS_SMALL + SM_W2T) + (l * 2 + kv) * 4096,
                       (const float*)(ws + WS_SMALL + SM_POSB) + (l * 2 + kv) * 64, kv ? VC : KC, (unsigned char*)lds, bg, kv, nt);
        }
        __syncthreads();
    }
    if constexpr (s == 4) {
        if (bid < 64) hg::phase2((const float*)(msc + WS_HG_DS), (const float*)(msc + WS_HG_GAM), (bf16_t*)(msc + WS_HG_ST), bid * NT + tid);
        if (bid >= 64 && bid < 68) s5::phase2((const float*)(msc + WS_S5_XE), (const float*)(ws + WS_SMALL + SM_A64) + l * 2048, (bf16_t*)(msc + WS_S5_XC), (bid - 64) * NT + tid);
        nsa::fill_btab(p.in[25], (unsigned char*)lds);
        __syncthreads();
        for (int w = bid; w < 256; w += nb) {
            const int bg = w >> 6, i = w & 63;
            for (int rep = 0; rep < 2; ++rep) nsa::cmpwin_item(HZ, KC, VC, (unsigned*)(msc + WS_SELMASK), Y, (unsigned char*)lds, bg, rep ? 127 - i : i);
        }
    }
    if constexpr (s == 5) {
        for (int item = bid; item < 256; item += nb) s5::phase3(p, l, HZ, ws + WS_S5T + (size_t)l * s5::T_LAYER, (const bf16_t*)(msc + WS_S5_XC), Y, (unsigned char*)lds, item);
        for (int item = bid; item < 1024; item += nb) hg::phase3(HZ, LB + l * 256, p.in[18] + l * 64, (const bf16_t*)(msc + WS_HG_ST), Y, (unsigned char*)lds, item);
        nsa::fill_btab(p.in[25], (unsigned char*)lds);
        __syncthreads();
        for (int w = bid; w < 256; w += nb) {
            const int bg = w >> 6, i = w & 63;
            for (int rep = 0; rep < 2; ++rep) nsa::slc_item(HZ, (const unsigned*)(msc + WS_SELMASK), Y, (unsigned char*)lds, bg, rep ? 127 - i : i, dsc);
        }
    }
    if constexpr (s == 6) gemm_stage<pg8::EpiGLU, false>(lds, Y, (const bf16_t*)(ws + WS_SMALL + SM_WGLU) + l * 65536, 256, 256, pg8::EpiGLU{Y}, DM);
    if constexpr (s == 7) gemm_stage(lds, Y, (const bf16_t*)(wl + W_OUT), DM, DM, pg8::EpiResB<false, false>{nullptr, p.X, XB, SSQ, 1.0f * dsc});
    if constexpr (s == 8) {
        gemm_stage(lds, XB, (const bf16_t*)(wl + W_GU2), 2 * DFF, DM, pg8::EpiGU{SSQ, HZ, DFF});
        if constexpr (l == 0) { if (nb == 256 && bid >= 128) convert_group<1, 1>(p, lds, (bid - 128) * NWAVE + wave, 128 * NWAVE); else if (nb != 256) convert_group<1, 1>(p, lds, bid * NWAVE + wave, nb * NWAVE); }
    }
    if constexpr (s == 9) gemm_stage(lds, HZ, (const bf16_t*)(wl + W_D2), DM, DFF, pg8::EpiResB<false, (l == 1)>{nullptr, p.X, XB, SSQ, 0.5f * dsc});
}

template <int ST>
__device__ __forceinline__ void run_all(const Params& p, float* lds, cg::grid_group& grid, const XcdBarrier& bar) {
#ifdef DUP_ST
    if (ST == DUP_ST) { run_stage<ST>(p, lds, 0.0f); xcd_barrier(bar); }
#endif
    if (p.st_lo <= ST && ST < p.st_hi) {
        run_stage<ST>(p, lds);
        if (ST + 1 < p.st_hi) { if (p.st_hi < 0) grid.sync(); else xcd_barrier(bar); }
    }
    if constexpr (ST + 1 < NSTAGES) run_all<ST + 1>(p, lds, grid, bar);
}

__global__ void __launch_bounds__(NT, 2) fwd_kernel(Params p) {
    extern __shared__ __attribute__((aligned(16))) unsigned char lds_raw[];
    cg::grid_group grid = cg::this_grid();
    float* lds = (float*)lds_raw;
    volatile LAS unsigned* bst = (volatile LAS unsigned*)((LAS unsigned char*)lds_raw + LDS_BYTES - 64);
    if (tidx() < 16) bst[tidx()] = 0u;
    __syncthreads();
    const XcdBarrier bar = xcd_barrier_post((unsigned*)(p.ws + WS_CTL) + 1024, bst);
    run_all<0>(p, lds, grid, bar);
}

extern "C" void kernel_launch(void* const* d_in, const int* in_sizes, int n_in,
                              void* d_out, int out_size, void* d_ws, size_t ws_size,
                              hipStream_t stream) {
    static int grid_blocks = 0;
    if (!grid_blocks) {
        int dev = 0, cus = 0, per_cu = 0;
        (void)hipGetDevice(&dev);
        (void)hipDeviceGetAttribute(&cus, hipDeviceAttributeMultiprocessorCount, dev);
        (void)hipFuncSetAttribute((const void*)fwd_kernel, hipFuncAttributeMaxDynamicSharedMemorySize, LDS_BYTES);
        (void)hipOccupancyMaxActiveBlocksPerMultiprocessor(&per_cu, (const void*)fwd_kernel, NT, LDS_BYTES);
        if (per_cu < 1) { fprintf(stderr, "occupancy query says %d blocks/CU\n", per_cu); per_cu = 1; }
        grid_blocks = cus;
        if (ws_size < WS_END) fprintf(stderr, "workspace too small: %zu < %zu\n", ws_size, (size_t)WS_END);
    }
    Params p{};
    for (int i = 0; i < 31; ++i) p.in[i] = (const float*)d_in[i];
    p.X = (float*)d_out; p.ws = (unsigned char*)d_ws; p.st_lo = 0; p.st_hi = NSTAGES;
    (void)hipMemsetAsync((char*)d_ws + WS_CTL, 0, 65536, stream);
    void* args[] = {&p};
    hipError_t e = hipLaunchCooperativeKernel((void*)fwd_kernel, dim3(grid_blocks), dim3(NT), args, LDS_BYTES, stream);
    if (e != hipSuccess) fprintf(stderr, "cooperative launch failed: %s (grid %d)\n", hipGetErrorString(e), grid_blocks);
}
```

```cpp
#include <hip/hip_runtime.h>
#include <hip/hip_cooperative_groups.h>
#include <cstdio>
#include <cstdint>
namespace cg = cooperative_groups;

typedef unsigned short bf16_t;
typedef float f32x4 __attribute__((ext_vector_type(4)));
__device__ __forceinline__ int tidx() { int t = __builtin_amdgcn_workitem_id_x(); asm volatile("" : "+v"(t)); return t; }

constexpr int BSZ = 2, SEQ = 8192, DM = 1024, MTOK = BSZ * SEQ, DFF = 2816, DIN = 2584, ZLD = 2816;
constexpr int NT = 512, NWAVE = 8;
constexpr int LDS_BYTES = 147456;
constexpr float EPS = 1e-6f;
constexpr int ZC_U = 0, ZC_HQ = 256, ZC_HF = 512, ZC_HI = 768, ZC_HG = 1024, ZC_NQ = 1280, ZC_NKV = 1792, ZC_NG = 2560;
constexpr int NCMP = 511;

constexpr size_t MiB = 1u << 20;
constexpr size_t WS_CTL = 0;
constexpr size_t WS_W = 1 * MiB;
constexpr size_t W_GU1 = 0, W_D1 = 11 * MiB, W_IN = W_D1 + 5632 * 1024, W_OUT = W_IN + 5632 * 1024, W_GU2 = W_OUT + 2 * MiB, W_D2 = W_GU2 + 11 * MiB, W_LAYER = W_D2 + 5632 * 1024;
constexpr size_t WS_SMALL = WS_W + 2 * W_LAYER;
constexpr size_t SM_SSQ = 0;
constexpr size_t SM_S5AB = 1048576;
constexpr size_t SM_S5_LAYER = 139264;
constexpr size_t SM_LB = SM_S5AB + 2 * SM_S5_LAYER;
constexpr size_t SM_KC = SM_LB + 2048;
constexpr size_t SM_VC = SM_KC + 524288;
constexpr size_t SM_A64 = SM_VC + 524288;
constexpr size_t SM_WGLU = SM_A64 + 16384;
constexpr size_t SM_W1T = SM_WGLU + 262144;
constexpr size_t SM_W2T = SM_W1T + 1048576;
constexpr size_t SM_POSB = SM_W2T + 32768;
constexpr size_t SM_END = SM_POSB + 1024;
static_assert(SM_END <= 4 * MiB, "small region");
constexpr size_t WS_XB = WS_SMALL + 4 * MiB;
constexpr size_t WS_HG_DS = 0, WS_HG_ST = 16 * MiB, WS_HG_GAM = 24 * MiB;
constexpr size_t WS_HZ = WS_XB + 32 * MiB;
constexpr size_t WS_Y = WS_HZ + 88 * MiB;
constexpr size_t WS_S5T = WS_Y + 32 * MiB;
constexpr size_t WS_END = WS_S5T + 2 * 8921088;
constexpr size_t WS_POW = WS_Y;
constexpr size_t WS_S5_XE = 25 * MiB, WS_S5_XC = 27 * MiB, WS_SELMASK = 28 * MiB;
static_assert(WS_END <= 256 * MiB, "workspace");

struct Params {
    const float* in[31];
    float* X;
    unsigned char* ws;
    int st_lo, st_hi;
};

namespace pg8 {
#define PG8_LAS __attribute__((address_space(3)))
typedef unsigned short bf16_t;
typedef short bf16x8 __attribute__((ext_vector_type(8)));
typedef float f32x4 __attribute__((ext_vector_type(4)));
typedef unsigned u32x4 __attribute__((ext_vector_type(4)));
constexpr int BM = 256, BK = 64, HALF = 128, HTB = HALF * BK * 2  , STAGE_BYTES = 8 * HTB, NXCD = 8, WGM = 8;

__host__ __device__ __forceinline__ int lds_byte(int r, int c) { const int st = (r >> 4) * 2 + (c >> 5), rr = r & 15, cc = c & 31, ob = rr * 64 + cc * 2; return st * 1024 + (ob ^ (((ob >> 9) & 1) << 5)); }
__host__ __device__ __forceinline__ void stage_rc(int b, int& R, int& C) { const int st = b / 1024, sb = b % 1024, swz = sb ^ (((sb >> 9) & 1) << 5); R = (st >> 1) * 16 + swz / 64; C = (st & 1) * 32 + (swz % 64) / 2; }
__host__ __device__ __forceinline__ int perm32(int rho) { const int n = rho >> 4, i = rho & 15; return 8 * (i >> 2) + 4 * n + (i & 3); }

struct Unit { int pm, pn; };
struct Gemm { const bf16_t* A; const bf16_t* Bt; int M, N, K, lda; };

struct StaticOrder {
    int nM, nN, nwg, G, c;
    __host__ __device__ void init(int M, int N, int G_, int c_) { nM = M / BM; nN = N / BM; nwg = nM * nN; G = G_; c = c_; }
    __host__ __device__ bool next(int i, Unit& u) const {
        const long L = (long)i * G + c; if (L >= nwg) return false;
        int wgid = (int)L; { const int q = nwg / NXCD, r = nwg % NXCD, xcd = wgid % NXCD, off = wgid / NXCD; wgid = (xcd < r ? xcd * (q + 1) : r * (q + 1) + (xcd - r) * q) + off; }
        const int nig = WGM * nN, gid = wgid / nig, fm = gid * WGM, gsz = (nM - fm) < WGM ? (nM - fm) : WGM;
        u.pm = fm + ((wgid % nig) % gsz); u.pn = (wgid % nig) / gsz; return true;
    }
    __device__ __forceinline__ void a_ready(const Unit&) const {}
    __device__ __forceinline__ void done(const Unit&) const {}
};

__device__ __forceinline__ unsigned cvt_pk_bf16(float lo, float hi) { unsigned r; asm volatile("v_cvt_pk_bf16_f32 %0, %1, %2" : "=v"(r) : "v"(lo), "v"(hi)); return r; }

__device__ __forceinline__ float rstd16(const float* ssq16, int row) {
    const f32x4* s = (const f32x4*)(ssq16 + 16 * (size_t)row);
    const f32x4 a = s[0], b = s[1], c = s[2], d = s[3];
    const float t = ((a[0] + a[1]) + (a[2] + a[3])) + ((b[0] + b[1]) + (b[2] + b[3])) + ((c[0] + c[1]) + (c[2] + c[3])) + ((d[0] + d[1]) + (d[2] + d[3]));
    return __builtin_amdgcn_rsqf(t * (1.0f / 1024.0f) + 1e-6f);
}
__device__ __forceinline__ float silu_f(float x) { return x * __builtin_amdgcn_rcpf(1.0f + __builtin_amdgcn_exp2f(-1.4426950408889634f * x)); }
typedef unsigned u32x2 __attribute__((ext_vector_type(2)));
struct EpiGU {
    static constexpr bool PERM = true, AFTER_DRAIN = false;
    const float* ssq16; bf16_t* H; int ldh;
    __device__ __forceinline__ void operator()(const f32x4 (&acc)[2][2][4][2], const Unit& u, int wr, int wc, int fr, int fq) const {
#pragma unroll
        for (int ai = 0; ai < 2; ++ai)
#pragma unroll
            for (int m = 0; m < 4; ++m) {
                const int row = u.pm * BM + ai * HALF + wr * 64 + m * 16 + fr;
                const float rs = rstd16(ssq16, row);
                const f32x4 g0 = acc[ai][0][m][0] * rs, g1 = acc[ai][0][m][1] * rs, u0 = acc[ai][1][m][0] * rs, u1 = acc[ai][1][m][1] * rs;
                u32x4 w;
                w.x = cvt_pk_bf16(silu_f(g0[0]) * u0[0], silu_f(g0[1]) * u0[1]); w.y = cvt_pk_bf16(silu_f(g0[2]) * u0[2], silu_f(g0[3]) * u0[3]);
                w.z = cvt_pk_bf16(silu_f(g1[0]) * u1[0], silu_f(g1[1]) * u1[1]); w.w = cvt_pk_bf16(silu_f(g1[2]) * u1[2], silu_f(g1[3]) * u1[3]);
                *(u32x4*)(H + (size_t)row * ldh + u.pn * HALF + wc * 32 + 8 * fq) = w;
            }
    }
};
template <bool WXB = true>
struct EpiResT {
    static constexpr bool PERM = true, AFTER_DRAIN = false;
    const float* Xin; float* X; bf16_t* XB; float* ssq16; float scale;
    __device__ __forceinline__ void operator()(const f32x4 (&acc)[2][2][4][2], const Unit& u, int wr, int wc, int fr, int fq) const {
#pragma unroll
        for (int ai = 0; ai < 2; ++ai)
#pragma unroll
            for (int m = 0; m < 4; ++m) {
                const int row = u.pm * BM + ai * HALF + wr * 64 + m * 16 + fr;
                float ss = 0.f;
#pragma unroll
                for (int bj = 0; bj < 2; ++bj) {
                    const int col0 = u.pn * BM + bj * HALF + wc * 32 + 8 * fq;
                    float* px = X + (size_t)row * 1024 + col0; const float* pi = Xin + (size_t)row * 1024 + col0;
                    f32x4 x0 = *(const f32x4*)pi, x1 = *(const f32x4*)(pi + 4);
                    x0 = x0 + acc[ai][bj][m][0] * scale; x1 = x1 + acc[ai][bj][m][1] * scale;
                    *(f32x4*)px = x0; *(f32x4*)(px + 4) = x1;
                    ss += ((x0[0] * x0[0] + x0[1] * x0[1]) + (x0[2] * x0[2] + x0[3] * x0[3])) + ((x1[0] * x1[0] + x1[1] * x1[1]) + (x1[2] * x1[2] + x1[3] * x1[3]));
                    if (WXB) {
                        u32x4 w; w.x = cvt_pk_bf16(x0[0], x0[1]); w.y = cvt_pk_bf16(x0[2], x0[3]); w.z = cvt_pk_bf16(x1[0], x1[1]); w.w = cvt_pk_bf16(x1[2], x1[3]);
                        *(u32x4*)(XB + (size_t)row * 1024 + col0) = w;
                    }
                }
                ss += __shfl_xor(ss, 16); ss += __shfl_xor(ss, 32);
                if (fq == 0) ssq16[(size_t)row * 16 + u.pn * 4 + wc] = ss;
            }
    }
};
template <bool INF32, bool OUTF32>
struct EpiResB {
    static constexpr bool PERM = true, AFTER_DRAIN = false;
    const float* Xin; float* Xout; bf16_t* XB; float* ssq16; float scale;
    __device__ __forceinline__ void operator()(const f32x4 (&acc)[2][2][4][2], const Unit& u, int wr, int wc, int fr, int fq) const {
#pragma unroll
        for (int ai = 0; ai < 2; ++ai)
#pragma unroll
            for (int m = 0; m < 4; ++m) {
                const int row = u.pm * BM + ai * HALF + wr * 64 + m * 16 + fr;
                float ss = 0.f;
#pragma unroll
                for (int bj = 0; bj < 2; ++bj) {
                    const int col0 = u.pn * BM + bj * HALF + wc * 32 + 8 * fq;
                    f32x4 x0, x1;
                    if (INF32) { const float* pi = Xin + (size_t)row * 1024 + col0; x0 = *(const f32x4*)pi; x1 = *(const f32x4*)(pi + 4); }
                    else {
                        const u32x4 w = *(const u32x4*)(XB + (size_t)row * 1024 + col0);
                        x0 = (f32x4){__uint_as_float(w.x << 16), __uint_as_float(w.x & 0xffff0000u), __uint_as_float(w.y << 16), __uint_as_float(w.y & 0xffff0000u)};
                        x1 = (f32x4){__uint_as_float(w.z << 16), __uint_as_float(w.z & 0xffff0000u), __uint_as_float(w.w << 16), __uint_as_float(w.w & 0xffff0000u)};
                    }
                    x0 = x0 + acc[ai][bj][m][0] * scale; x1 = x1 + acc[ai][bj][m][1] * scale;
                    ss += ((x0[0] * x0[0] + x0[1] * x0[1]) + (x0[2] * x0[2] + x0[3] * x0[3])) + ((x1[0] * x1[0] + x1[1] * x1[1]) + (x1[2] * x1[2] + x1[3] * x1[3]));
                    if (OUTF32) { float* px = Xout + (size_t)row * 1024 + col0; *(f32x4*)px = x0; *(f32x4*)(px + 4) = x1; }
                    else {
                        u32x4 w; w.x = cvt_pk_bf16(x0[0], x0[1]); w.y = cvt_pk_bf16(x0[2], x0[3]); w.z = cvt_pk_bf16(x1[0], x1[1]); w.w = cvt_pk_bf16(x1[2], x1[3]);
                        *(u32x4*)(XB + (size_t)row * 1024 + col0) = w;
                    }
                }
                ss += __shfl_xor(ss, 16); ss += __shfl_xor(ss, 32);
                if (fq == 0) ssq16[(size_t)row * 16 + u.pn * 4 + wc] = ss;
            }
    }
};
struct EpiZ {
    static constexpr bool PERM = true, AFTER_DRAIN = false;
    const float* ssq16; bf16_t* Z; int ldz;
    __device__ __forceinline__ void operator()(const f32x4 (&acc)[2][2][4][2], const Unit& u, int wr, int wc, int fr, int fq) const {
#pragma unroll
        for (int ai = 0; ai < 2; ++ai)
#pragma unroll
            for (int m = 0; m < 4; ++m) {
                const int row = u.pm * BM + ai * HALF + wr * 64 + m * 16 + fr;
                const float rs = rstd16(ssq16, row);
#pragma unroll
                for (int bj = 0; bj < 2; ++bj) {
                    const int col0 = u.pn * BM + bj * HALF + wc * 32 + 8 * fq;
                    const f32x4 v0 = acc[ai][bj][m][0] * rs, v1 = acc[ai][bj][m][1] * rs;
                    u32x4 w; w.x = cvt_pk_bf16(v0[0], v0[1]); w.y = cvt_pk_bf16(v0[2], v0[3]); w.z = cvt_pk_bf16(v1[0], v1[1]); w.w = cvt_pk_bf16(v1[2], v1[3]);
                    *(u32x4*)(Z + (size_t)row * ldz + col0) = w;
                }
            }
    }
};
template <class Epi, class Sched, bool ALIGN_EPI = false, bool SP2 = false, bool LDAK = true>
__device__ __forceinline__ void gemm_phase(PG8_LAS unsigned char* lds, const Gemm g, const Sched& S, const Epi& E) {
    const int tid = tidx(), wid = __builtin_amdgcn_readfirstlane(tid >> 6), lane = tid & 63, wr = wid >> 2, wc = wid & 3, fr = lane & 15, fq = lane >> 4;
    const int K = g.K, nt = K / BK;
    unsigned voffA[2], voffB[2];
#pragma unroll
    for (int i = 0; i < 2; ++i) { int R, C; stage_rc(tid * 16 + i * 8192, R, C); const int Rb = Epi::PERM ? ((R & ~31) + perm32(R & 31)) : R;
        voffA[i] = (unsigned)(R * (LDAK ? K : g.lda) + C) * 2u; voffB[i] = (unsigned)(Rb * K + C) * 2u; }
    const size_t kstep = (size_t)(BK * 2);
    const size_t hstep = (size_t)HALF * K * 2;
    const size_t tstep = 2 * hstep;
    const size_t hstepA = LDAK ? hstep : (size_t)HALF * g.lda * 2, tstepA = 2 * hstepA;
    const unsigned ldsw = (unsigned)wid * 1024u;
    const int aoff = lds_byte(wr * 64 + fr, fq * 8), boff = lds_byte(wc * 32 + fr, fq * 8);
#define PG8_SA(b, h) (((b) * 2 + (h)) * HTB)
#define PG8_SB(b, h) ((4 + (b) * 2 + (h)) * HTB)
#define PG8_STAGE(bufoff, gbase, voff) do { _Pragma("unroll") for (int _i = 0; _i < 2; ++_i) \
        __builtin_amdgcn_global_load_lds((const unsigned*)((const char*)(gbase) + (voff)[_i]), (PG8_LAS unsigned*)(lds + (bufoff) + ldsw + _i * 8192), 16, 0, 0); } while (0)
#define PG8_LDA(dst, b, h) do { _Pragma("unroll") for (int m = 0; m < 4; ++m) _Pragma("unroll") for (int k = 0; k < 2; ++k) dst[m][k] = *(const PG8_LAS bf16x8*)(lds + PG8_SA(b, h) + aoff + m * 2048 + k * 1024); } while (0)
#define PG8_LDB(dst, b, h) do { _Pragma("unroll") for (int n = 0; n < 2; ++n) _Pragma("unroll") for (int k = 0; k < 2; ++k) dst[n][k] = *(const PG8_LAS bf16x8*)(lds + PG8_SB(b, h) + boff + n * 2048 + k * 1024); } while (0)
#define PG8_MMA(ai, bj, At, Bt) do { __builtin_amdgcn_s_setprio(1); _Pragma("unroll") for (int m = 0; m < 4; ++m) _Pragma("unroll") for (int n = 0; n < 2; ++n) _Pragma("unroll") for (int k = 0; k < 2; ++k) \
        acc[ai][bj][m][n] = __builtin_amdgcn_mfma_f32_16x16x32_bf16(Bt[n][k], At[m][k], acc[ai][bj][m][n], 0, 0, 0); __builtin_amdgcn_s_setprio(0); } while (0)
#define PG8_WAIT_V(n) asm volatile("s_waitcnt vmcnt(" #n ")" ::: "memory")
#define PG8_WAIT_L(n) asm volatile("s_waitcnt lgkmcnt(" #n ")" ::: "memory")
#define PG8_BAR __builtin_amdgcn_s_barrier()
#define PG8_SCHED __builtin_amdgcn_sched_barrier(0)
    Unit cur, nxt; int ui = 0;
    if (!S.next(0, cur)) return;
    f32x4 acc[2][2][4][2];
#pragma unroll
    for (int a = 0; a < 2; ++a)
#pragma unroll
        for (int b = 0; b < 2; ++b)
#pragma unroll
            for (int m = 0; m < 4; ++m)
#pragma unroll
                for (int n = 0; n < 2; ++n) acc[a][b][m][n] = (f32x4){0.f, 0.f, 0.f, 0.f};
    bf16x8 At[4][2], B0[2][2], B1[2][2];
    const char* cA = (const char*)g.A + (size_t)cur.pm * tstepA; const char* cB = (const char*)g.Bt + (size_t)cur.pn * tstep;
    S.a_ready(cur);
    if constexpr (SP2) {
        PG8_STAGE(PG8_SB(0, 0), cB, voffB); PG8_STAGE(PG8_SB(0, 1), cB + hstep, voffB); PG8_STAGE(PG8_SA(0, 0), cA, voffA); PG8_STAGE(PG8_SA(0, 1), cA + hstepA, voffA);
        if (wr == 1) PG8_BAR;
        PG8_WAIT_V(2); PG8_BAR;
        PG8_STAGE(PG8_SB(1, 0), cB + kstep, voffB); PG8_STAGE(PG8_SA(1, 0), cA + kstep, voffA); PG8_STAGE(PG8_SB(1, 1), cB + hstep + kstep, voffB);
        PG8_WAIT_V(6); PG8_BAR;
    } else {
        PG8_STAGE(PG8_SB(0, 0), cB, voffB); PG8_STAGE(PG8_SA(0, 0), cA, voffA); PG8_STAGE(PG8_SB(0, 1), cB + hstep, voffB); PG8_STAGE(PG8_SA(0, 1), cA + hstepA, voffA);
        if (wr == 1) PG8_BAR;
        PG8_WAIT_V(4); PG8_BAR;
        PG8_STAGE(PG8_SB(1, 0), cB + kstep, voffB); PG8_STAGE(PG8_SA(1, 0), cA + kstep, voffA); PG8_STAGE(PG8_SB(1, 1), cB + hstep + kstep, voffB);
        PG8_WAIT_V(6); PG8_BAR;
    }
    for (;;) {
        const bool has_next = S.next(ui + 1, nxt);
        const char* nA = has_next ? (const char*)g.A + (size_t)nxt.pm * tstepA : cA; const char* nB = has_next ? (const char*)g.Bt + (size_t)nxt.pn * tstep : cB;
        for (int t = 0; t < nt; t += 2) {
            const bool last = (t == nt - 2);
            const char* a1 = cA + (size_t)(t + 1) * kstep;
            const char* a2 = last ? nA : cA + (size_t)(t + 2) * kstep; const char* b2 = last ? nB : cB + (size_t)(t + 2) * kstep;
            const char* a3 = a2 + kstep; const char* b3 = b2 + kstep;
            if (last && has_next) S.a_ready(nxt);
            if constexpr (SP2) {
            PG8_LDB(B0, 0, 0); PG8_LDB(B1, 0, 1); PG8_SCHED; PG8_LDA(At, 0, 0); PG8_STAGE(PG8_SA(1, 1), a1 + hstepA, voffA);
            PG8_WAIT_V(8); PG8_WAIT_L(0); PG8_BAR; PG8_MMA(0, 0, At, B0); PG8_MMA(0, 1, At, B1); PG8_BAR; PG8_SCHED;
            PG8_LDA(At, 0, 1); PG8_STAGE(PG8_SB(0, 0), b2, voffB); PG8_STAGE(PG8_SB(0, 1), b2 + hstep, voffB); PG8_STAGE(PG8_SA(0, 0), a2, voffA);
            PG8_WAIT_V(8); PG8_WAIT_L(0); PG8_BAR; PG8_MMA(1, 0, At, B0); PG8_MMA(1, 1, At, B1); PG8_BAR; PG8_SCHED;
            PG8_LDB(B0, 1, 0); PG8_LDB(B1, 1, 1); PG8_SCHED; PG8_LDA(At, 1, 0); PG8_STAGE(PG8_SA(0, 1), a2 + hstepA, voffA);
            PG8_WAIT_V(8); PG8_WAIT_L(0); PG8_BAR; PG8_MMA(0, 0, At, B0); PG8_MMA(0, 1, At, B1); PG8_BAR; PG8_SCHED;
            PG8_LDA(At, 1, 1); PG8_STAGE(PG8_SB(1, 0), b3, voffB); PG8_STAGE(PG8_SB(1, 1), b3 + hstep, voffB); PG8_STAGE(PG8_SA(1, 0), a3, voffA);
            PG8_WAIT_V(8); PG8_WAIT_L(0); PG8_BAR; PG8_MMA(1, 0, At, B0); PG8_MMA(1, 1, At, B1); PG8_BAR; PG8_SCHED;
            } else {
            PG8_LDB(B0, 0, 0); PG8_SCHED; PG8_LDA(At, 0, 0); PG8_STAGE(PG8_SA(1, 1), a1 + hstepA, voffA);
            PG8_WAIT_L(8); PG8_BAR; PG8_WAIT_L(0); PG8_MMA(0, 0, At, B0); PG8_BAR; PG8_SCHED;
            PG8_LDB(B1, 0, 1); PG8_STAGE(PG8_SB(0, 0), b2, voffB);
            PG8_BAR; PG8_WAIT_L(0); PG8_MMA(0, 1, At, B1); PG8_BAR;
            PG8_LDA(At, 0, 1); PG8_STAGE(PG8_SA(0, 0), a2, voffA);
            PG8_BAR; PG8_WAIT_L(0); PG8_MMA(1, 0, At, B0); PG8_BAR; PG8_SCHED;
            PG8_STAGE(PG8_SB(0, 1), b2 + hstep, voffB);
            PG8_WAIT_V(6); PG8_BAR; PG8_MMA(1, 1, At, B1); PG8_BAR;
            PG8_LDB(B0, 1, 0); PG8_SCHED; PG8_LDA(At, 1, 0); PG8_STAGE(PG8_SA(0, 1), a2 + hstepA, voffA);
            PG8_WAIT_L(8); PG8_BAR; PG8_WAIT_L(0); PG8_MMA(0, 0, At, B0); PG8_BAR; PG8_SCHED;
            PG8_LDB(B1, 1, 1); PG8_STAGE(PG8_SB(1, 0), b3, voffB);
            PG8_BAR; PG8_WAIT_L(0); PG8_MMA(0, 1, At, B1); PG8_BAR;
            PG8_LDA(At, 1, 1); PG8_STAGE(PG8_SA(1, 0), a3, voffA);
            PG8_BAR; PG8_WAIT_L(0); PG8_MMA(1, 0, At, B0); PG8_BAR; PG8_SCHED;
            PG8_STAGE(PG8_SB(1, 1), b3 + hstep, voffB);
            PG8_WAIT_V(6); PG8_BAR; PG8_MMA(1, 1, At, B1); PG8_BAR;
            }
        }
        if constexpr (ALIGN_EPI) { if (wr == 0) PG8_BAR; }
        if constexpr (!Epi::AFTER_DRAIN) { E(acc, cur, wr, wc, fr, fq); S.done(cur); }
        if (!has_next) break;
#pragma unroll
        for (int a = 0; a < 2; ++a)
#pragma unroll
            for (int b = 0; b < 2; ++b)
#pragma unroll
                for (int m = 0; m < 4; ++m)
#pragma unroll
                    for (int n = 0; n < 2; ++n) acc[a][b][m][n] = (f32x4){0.f, 0.f, 0.f, 0.f};
        cur = nxt; cA = nA; cB = nB; ++ui;
        if constexpr (ALIGN_EPI) { if (wr == 1) PG8_BAR; }
    }
    PG8_WAIT_V(0);
    if constexpr (!ALIGN_EPI) { if (wr == 0) PG8_BAR; }
    PG8_BAR;
    if constexpr (Epi::AFTER_DRAIN) { E.fused(acc, cur, wr, wc, fr, fq, lds, wid, lane); S.done(cur); }
#undef PG8_SA
#undef PG8_SB
#undef PG8_STAGE
#undef PG8_LDA
#undef PG8_LDB
#undef PG8_MMA
#undef PG8_WAIT_V
#undef PG8_WAIT_L
#undef PG8_BAR
#undef PG8_SCHED
}
}

#define WAVE_SYNC() asm volatile("s_waitcnt vmcnt(0) lgkmcnt(0)" ::: "memory")
__device__ __forceinline__ float bf2f(bf16_t v) { return __uint_as_float(((unsigned)v) << 16); }
__device__ __forceinline__ bf16_t f2bf(float f) { unsigned u = __float_as_uint(f); return (bf16_t)((u + 0x7fffu + ((u >> 16) & 1u)) >> 16); }
__device__ __forceinline__ float sigmoidf_(float x) { return 1.f / (1.f + expf(-x)); }
__device__ __forceinline__ float siluf_(float x) { return x * sigmoidf_(x); }
__device__ __forceinline__ float gelu_tanh(float x) { const float x3 = x * x * x; return 0.5f * x * (1.f + tanhf(0.7978845608028654f * (x + 0.044715f * x3))); }
__device__ __forceinline__ float wave_sum(float v) {
#pragma unroll
    for (int o = 1; o < 64; o <<= 1) v += __shfl_xor(v, o);
    return v;
}
__device__ __forceinline__ float wave_max(float v) {
#pragma unroll
    for (int o = 1; o < 64; o <<= 1) v = fmaxf(v, __shfl_xor(v, o));
    return v;
}
__device__ __forceinline__ int t5_bucket(int n) {
    if (n < 16) return n;
    const float v = logf((float)n / 16.f) / 4.1588830833596715f * 16.f;
    int b = 16 + (int)v;
    return b < 31 ? b : 31;
}
__device__ __forceinline__ float rstd_of(const float* ssq, int r) { return pg8::rstd16(ssq, r); }

__device__ __forceinline__ void cw_item(const float* W, int K, int N, const float* gain, bf16_t* Bt, int rs, int ro, float* scr, int item, int lane) {
    const int nblk = (N + 31) >> 5, kb = item / nblk, nbk = item - kb * nblk, k0 = 64 * kb, n0 = 32 * nbk;
    const int nn = n0 + (lane & 31); const bool nok = nn < N;
    float v[32];
    const float* wp = W + (size_t)(k0 + (lane >> 5)) * N + nn;
#pragma unroll
    for (int i = 0; i < 32; ++i) v[i] = nok ? wp[(size_t)(2 * i) * N] : 0.f;
    if (gain) {
#pragma unroll
        for (int i = 0; i < 32; ++i) v[i] *= gain[k0 + 2 * i + (lane >> 5)];
    }
#pragma unroll
    for (int i = 0; i < 32; ++i) scr[(2 * i + (lane >> 5)) * 33 + (lane & 31)] = v[i];
    WAVE_SYNC();
    const int c = lane & 7;
#pragma unroll
    for (int j = 0; j < 4; ++j) {
        const int n = (lane >> 3) + 8 * j; const float* sp = scr + (8 * c) * 33 + n;
        pg8::u32x4 o; o.x = pg8::cvt_pk_bf16(sp[0], sp[33]); o.y = pg8::cvt_pk_bf16(sp[66], sp[99]); o.z = pg8::cvt_pk_bf16(sp[132], sp[165]); o.w = pg8::cvt_pk_bf16(sp[198], sp[231]);
        const int nn2 = n0 + n, drow = rs ? (nn2 * rs + ro) : (((nn2 >> 7) << 8) + (nn2 & 127) + ro);
        if (nn2 < N) *(pg8::u32x4*)(Bt + (size_t)drow * K + k0 + 8 * c) = o;
    }
    WAVE_SYNC();
}
__device__ __forceinline__ void convert_wt(const float* W, int K, int N, const float* gain, bf16_t* Bt, int rs, int ro, float* lds, int& g, int NGW) {
    const int lane = tidx() & 63, wave = tidx() >> 6;
    const int nitems = (K >> 6) * ((N + 31) >> 5);
    float* scr = lds + wave * (64 * 33);
    while (g < nitems) { cw_item(W, K, N, gain, Bt, rs, ro, scr, g, lane); g += NGW; }
    g -= nitems;
}

__device__ __forceinline__ void rowstats(const float* src, float* X, bf16_t* XB, float* SSQ, int bid, int nb) {
    const int wave = tidx() >> 6, lane = tidx() & 63;
    for (int r = bid * NWAVE + wave; r < MTOK; r += nb * NWAVE) {
        float s = 0.f;
#pragma unroll
        for (int j = 0; j < 4; ++j) {
            const f32x4 v = *(const f32x4*)(src + (size_t)r * DM + j * 256 + lane * 4);
            s += (v.x * v.x + v.y * v.y) + (v.z * v.z + v.w * v.w);
            if (X != src) *(f32x4*)(X + (size_t)r * DM + j * 256 + lane * 4) = v;
            ushort4 o; o.x = f2bf(v.x); o.y = f2bf(v.y); o.z = f2bf(v.z); o.w = f2bf(v.w);
            *(ushort4*)(XB + (size_t)r * DM + j * 256 + lane * 4) = o;
        }
        s = wave_sum(s);
        if (lane < 16) SSQ[16 * (size_t)r + lane] = (lane == 0) ? s : 0.f;
    }
}

template <class Epi>
__device__ __forceinline__ void gemm_naive(const bf16_t* A, int lda, const bf16_t* Bt, int ldb, int Mrows, int N, int K, float* lds, int bid, int nb, Epi epi) {
    const int tid = tidx(), tx = tid & 31, ty = tid >> 5;
    float* As = lds;
    float* Bs = lds + 16 * 132;
    const int tn_n = N / 128, ntiles = (Mrows / 128) * tn_n;
    for (int tile = bid; tile < ntiles; tile += nb) {
        const int tm = tile / tn_n, tn = tile % tn_n;
        float acc[8][4];
#pragma unroll
        for (int i = 0; i < 8; ++i)
#pragma unroll
            for (int j = 0; j < 4; ++j) acc[i][j] = 0.f;
        const int lr = tid >> 2, lk = (tid & 3) * 4;
        const bf16_t* ap = A + (size_t)(tm * 128 + lr) * lda + lk;
        const bf16_t* bp = Bt + (size_t)(tn * 128 + lr) * ldb + lk;
        for (int k0 = 0; k0 < K; k0 += 16) {
            const ushort4 av = *(const ushort4*)(ap + k0);
            const ushort4 bv = *(const ushort4*)(bp + k0);
            __syncthreads();
            As[(lk + 0) * 132 + lr] = bf2f(av.x); As[(lk + 1) * 132 + lr] = bf2f(av.y); As[(lk + 2) * 132 + lr] = bf2f(av.z); As[(lk + 3) * 132 + lr] = bf2f(av.w);
            Bs[(lk + 0) * 132 + lr] = bf2f(bv.x); Bs[(lk + 1) * 132 + lr] = bf2f(bv.y); Bs[(lk + 2) * 132 + lr] = bf2f(bv.z); Bs[(lk + 3) * 132 + lr] = bf2f(bv.w);
            __syncthreads();
#pragma unroll 2
            for (int kk = 0; kk < 16; ++kk) {
                const f32x4 a0 = *(const f32x4*)(As + kk * 132 + ty * 8), a1 = *(const f32x4*)(As + kk * 132 + ty * 8 + 4);
                const f32x4 b = *(const f32x4*)(Bs + kk * 132 + tx * 4);
                const float a[8] = {a0.x, a0.y, a0.z, a0.w, a1.x, a1.y, a1.z, a1.w};
#pragma unroll
                for (int i = 0; i < 8; ++i) { acc[i][0] += a[i] * b.x; acc[i][1] += a[i] * b.y; acc[i][2] += a[i] * b.z; acc[i][3] += a[i] * b.w; }
            }
        }
#pragma unroll
        for (int i = 0; i < 8; ++i) epi(tm * 128 + ty * 8 + i, tn * 128 + tx * 4, acc[i]);
    }
}

struct EpiGU { const float* ssq; bf16_t* H;
    __device__ __forceinline__ void operator()(int r, int c, const float* a) const {
        const float rs = rstd_of(ssq, r);
        const float h0 = siluf_(a[0] * rs) * (a[1] * rs), h1 = siluf_(a[2] * rs) * (a[3] * rs);
        ushort2 o; o.x = f2bf(h0); o.y = f2bf(h1);
        *(ushort2*)(H + (size_t)r * DFF + (c >> 1)) = o; } };
struct EpiResid { float* X; float scale;
    __device__ __forceinline__ void operator()(int r, int c, const float* a) const {
        f32x4* p = (f32x4*)(X + (size_t)r * DM + c); f32x4 v = *p;
        v.x += scale * a[0]; v.y += scale * a[1]; v.z += scale * a[2]; v.w += scale * a[3]; *p = v; } };
struct EpiZ { const float* ssq; bf16_t* Z;
    __device__ __forceinline__ void operator()(int r, int c, const float* a) const {
        const float rs = rstd_of(ssq, r);
        ushort4 o; o.x = f2bf(a[0] * rs); o.y = f2bf(a[1] * rs); o.z = f2bf(a[2] * rs); o.w = f2bf(a[3] * rs);
        *(ushort4*)(Z + (size_t)r * ZLD + c) = o; } };

__device__ __forceinline__ void s5_tables(const Params& p, int l, float* tab  , int gtid, int gthreads) {
    const float* lam_re = p.in[8] + l * 1024; const float* lam_im = p.in[9] + l * 1024; const float* log_dt = p.in[10] + l * 16;
    const float* b_re = p.in[11] + l * 16384; const float* b_im = p.in[12] + l * 16384;
    for (int i = gtid; i < 16384; i += gthreads) {
        const int gp = i >> 4;
        const int g = gp >> 6;
        const float lr = lam_re[gp], li = lam_im[gp], dt = expf(log_dt[g]);
        const float mag = expf(lr * dt), are = mag * cosf(li * dt), aim = mag * sinf(li * dt);
        const float den = lr * lr + li * li, nr = are - 1.f, ni = aim;
        const float gre = (nr * lr + ni * li) / den, gim = (ni * lr - nr * li) / den;
        const float br = b_re[i], bi = b_im[i];
        tab[2048 + i] = gre * br - gim * bi;
        tab[2048 + 16384 + i] = gre * bi + gim * br;
        if ((i & 15) == 0) { tab[gp] = are; tab[1024 + gp] = aim; }
    }
}

__device__ __forceinline__ void s5_scan_naive(const Params& p, int l, const bf16_t* Z, float* S5PRE, const float* tab, float* lds, int item  ) {
    const int lane = tidx() & 63;
    const int b = item >> 4, g = item & 15;
    const float* c_re = p.in[13] + l * 16384 + g * 1024;
    const float* c_im = p.in[14] + l * 16384 + g * 1024;
    const float* dsk = p.in[15] + l * 256 + g * 16;
    float* us = lds;
    float* xr = lds + 1024;
    float* xi = xr + 64 * 65;
    float* cre = xi + 64 * 65;
    float* cim = cre + 1024;
    const float are = tab[g * 64 + lane], aim = tab[1024 + g * 64 + lane];
    float bbr[16], bbi[16];
#pragma unroll
    for (int h = 0; h < 16; ++h) { bbr[h] = tab[2048 + (g * 64 + lane) * 16 + h]; bbi[h] = tab[2048 + 16384 + (g * 64 + lane) * 16 + h]; }
    for (int i = lane; i < 1024; i += 64) { cre[i] = c_re[i]; cim[i] = c_im[i]; }
    float sr = 0.f, si = 0.f;
    for (int t0 = 0; t0 < SEQ; t0 += 64) {
        {
            const bf16_t* zp = Z + (size_t)(b * SEQ + t0 + lane) * ZLD + ZC_U + g * 16;
#pragma unroll
            for (int h = 0; h < 16; ++h) us[lane * 16 + h] = bf2f(zp[h]);
        }
        WAVE_SYNC();
        for (int s = 0; s < 64; ++s) {
            float bur = 0.f, bui = 0.f;
#pragma unroll
            for (int h = 0; h < 16; ++h) { const float u = us[s * 16 + h]; bur += u * bbr[h]; bui += u * bbi[h]; }
            const float nr = are * sr - aim * si + bur, ni = are * si + aim * sr + bui;
            sr = nr; si = ni;
            xr[s * 65 + lane] = sr; xi[s * 65 + lane] = si;
        }
        WAVE_SYNC();
        {
            float y[16];
#pragma unroll
            for (int h = 0; h < 16; ++h) y[h] = dsk[h] * us[lane * 16 + h];
            for (int pp = 0; pp < 64; ++pp) {
                const float a = xr[lane * 65 + pp], bq = xi[lane * 65 + pp];
#pragma unroll
                for (int h = 0; h < 16; ++h) y[h] += a * cre[h * 64 + pp] - bq * cim[h * 64 + pp];
            }
            float* o = S5PRE + (size_t)(b * SEQ + t0 + lane) * 256 + g * 16;
#pragma unroll
            for (int h = 0; h < 16; ++h) o[h] = y[h];
        }
        WAVE_SYNC();
    }
}

__device__ __forceinline__ void s5_post_naive(const Params& p, int l, const float* S5PRE, bf16_t* Y, float* lds, int bid, int nb) {
    const float* wglu = p.in[16] + l * 65536;
    const int tid = tidx(), half = tid >> 8, j = tid & 255;
    for (int r0 = bid * 2; r0 < MTOK; r0 += nb * 2) {
        __syncthreads();
        lds[tid] = gelu_tanh(S5PRE[(size_t)(r0 + half) * 256 + j]);
        __syncthreads();
        const float* yg = lds + half * 256;
        float acc = 0.f;
        for (int i = 0; i < 256; ++i) acc += yg[i] * wglu[i * 256 + j];
        Y[(size_t)(r0 + half) * DM + j] = f2bf(yg[j] * sigmoidf_(acc));
    }
}

__device__ __forceinline__ void hgrn_naive(const Params& p, int l, const bf16_t* Z, bf16_t* Y, const float* LB, float* lds, int item  ) {
    const int lane = tidx() & 63;
    const int b = item >> 2, h = item & 3;
    const float lb = LB[l * 256 + h * 64 + lane];
    const float gain = p.in[18][l * 64 + lane];
    float* qs = lds;
    float* fs = qs + 4096;
    float* ks = fs + 4096;
    float* vs = ks + 4096;
    float* gs = vs + 4096;
    float S[64];
#pragma unroll
    for (int d = 0; d < 64; ++d) S[d] = 0.f;
    for (int t0 = 0; t0 < SEQ; t0 += 64) {
        for (int s = 0; s < 64; ++s) {
            const bf16_t* zp = Z + (size_t)(b * SEQ + t0 + s) * ZLD + h * 64 + lane;
            const float q = bf2f(zp[ZC_HQ]), fl = bf2f(zp[ZC_HF]), iv = bf2f(zp[ZC_HI]), gv = bf2f(zp[ZC_HG]);
            qs[s * 64 + lane] = siluf_(q);
            fs[s * 64 + lane] = lb + (1.f - lb) * sigmoidf_(fl);
            ks[s * 64 + lane] = (1.f - lb) * sigmoidf_(-fl);
            vs[s * 64 + lane] = iv;
            gs[s * 64 + lane] = gv;
        }
        WAVE_SYNC();
        for (int s = 0; s < 64; ++s) {
            const float v = vs[s * 64 + lane];
            float o = 0.f;
#pragma unroll
            for (int d = 0; d < 64; d += 4) {
                const f32x4 f4 = *(const f32x4*)(fs + s * 64 + d), k4 = *(const f32x4*)(ks + s * 64 + d), q4 = *(const f32x4*)(qs + s * 64 + d);
                S[d] = f4.x * S[d] + k4.x * v; o += q4.x * S[d];
                S[d + 1] = f4.y * S[d + 1] + k4.y * v; o += q4.y * S[d + 1];
                S[d + 2] = f4.z * S[d + 2] + k4.z * v; o += q4.z * S[d + 2];
                S[d + 3] = f4.w * S[d + 3] + k4.w * v; o += q4.w * S[d + 3];
            }
            const float ms = wave_sum(o * o) * (1.f / 64.f);
            const float on = o * rsqrtf(ms + EPS) * gain * siluf_(gs[s * 64 + lane]);
            Y[(size_t)(b * SEQ + t0 + s) * DM + 256 + h * 64 + lane] = f2bf(on);
        }
        WAVE_SYNC();
    }
}

__device__ __forceinline__ void nsa_compress_naive(const Params& p, int l, const bf16_t* Z, bf16_t* KC, bf16_t* VC, float* lds_wave, int item) {
    const int lane = tidx() & 63;
    const int kv = item & 1, g = (item >> 1) & 1, rest = item >> 2, n = rest % NCMP, b = rest / NCMP;
    const float* pos = p.in[kv ? 22 : 19] + l * 2048;
    const float* w1 = p.in[kv ? 23 : 20] + (size_t)l * 131072;
    const float* w2 = p.in[kv ? 24 : 21] + l * 4096;
    const bf16_t* zp = Z + (size_t)(b * SEQ + 16 * n) * ZLD + ZC_NKV + kv * 128 + g * 64;
    float hsum = 0.f;
    for (int j = 0; j < 32; ++j) {
        const float xv = bf2f(zp[(size_t)j * ZLD + lane]) + pos[j * 64 + lane];
        for (int d = 0; d < 64; ++d) {
            const float xd = __shfl(xv, d);
            hsum += xd * w1[(size_t)(j * 64 + d) * 64 + lane];
        }
    }
    lds_wave[lane] = gelu_tanh(hsum);
    WAVE_SYNC();
    float o = 0.f;
    for (int m = 0; m < 64; ++m) o += lds_wave[m] * w2[m * 64 + lane];
    (kv ? VC : KC)[((size_t)(b * 2 + g) * 512 + n) * 64 + lane] = f2bf(o);
    if (n == 0) (kv ? VC : KC)[((size_t)(b * 2 + g) * 512 + 511) * 64 + lane] = 0;
    WAVE_SYNC();
}

__device__ __forceinline__ void nsa_attn_naive(const bf16_t* Z, const float* KC, const float* VC, bf16_t* Y, const float* btab, float* lw, int item) {
    const int lane = tidx() & 63;
    const int g = item & 1, bt = item >> 1, b = bt / SEQ, t = bt % SEQ;
    float* qs = lw;
    float* pc = lw + 256;
    float* pl = pc + 2048;
    int* sel = (int*)(pl + 256);
    const bf16_t* zrow = Z + (size_t)bt * ZLD;
#pragma unroll
    for (int r = 0; r < 4; ++r) qs[r * 64 + lane] = bf2f(zrow[ZC_NQ + g * 256 + r * 64 + lane]);
    for (int i = lane; i < 2048; i += 64) pc[i] = 0.f;
    WAVE_SYNC();
    const float* bt_g = btab + (g * 4) * 1024;
    float ocmp[4] = {0.f, 0.f, 0.f, 0.f};
    const int nval = t >= 31 ? min((t - 31) / 16 + 1, NCMP) : 0;
    if (nval > 0) {
        const float* kc = KC + (size_t)(b * 2 + g) * 512 * 64;
        const float* vc = VC + (size_t)(b * 2 + g) * 512 * 64;
        for (int i = 0; i < 8; ++i) {
            const int c = lane + 64 * i;
            float a0 = -1e30f, a1 = -1e30f, a2 = -1e30f, a3 = -1e30f;
            if (c < nval) {
                const float* kr = kc + c * 64;
                a0 = 0.f; a1 = 0.f; a2 = 0.f; a3 = 0.f;
#pragma unroll 4
                for (int d = 0; d < 64; ++d) { const float kd = kr[d]; a0 += qs[d] * kd; a1 += qs[64 + d] * kd; a2 += qs[128 + d] * kd; a3 += qs[192 + d] * kd; }
                const int dist = min(t - (16 * c + 31), 1023);
                a0 = a0 * 0.125f + bt_g[dist]; a1 = a1 * 0.125f + bt_g[1024 + dist]; a2 = a2 * 0.125f + bt_g[2048 + dist]; a3 = a3 * 0.125f + bt_g[3072 + dist];
            }
            pc[c] = a0; pc[512 + c] = a1; pc[1024 + c] = a2; pc[1536 + c] = a3;
        }
        for (int r = 0; r < 4; ++r) {
            float m = -1e30f;
            for (int i = 0; i < 8; ++i) m = fmaxf(m, pc[r * 512 + lane + 64 * i]);
            m = wave_max(m);
            float sum = 0.f;
            for (int i = 0; i < 8; ++i) { const int c = lane + 64 * i; const float e = (c < nval) ? expf(pc[r * 512 + c] - m) : 0.f; pc[r * 512 + c] = e; sum += e; }
            sum = wave_sum(sum);
            const float inv = 1.f / fmaxf(sum, 1e-30f);
            for (int i = 0; i < 8; ++i) pc[r * 512 + lane + 64 * i] *= inv;
        }
        WAVE_SYNC();
        for (int c = 0; c < nval; ++c) {
            const float v = vc[c * 64 + lane];
            ocmp[0] += pc[c] * v; ocmp[1] += pc[512 + c] * v; ocmp[2] += pc[1024 + c] * v; ocmp[3] += pc[1536 + c] * v;
        }
    }
    {
        float sc[2];
#pragma unroll
        for (int q = 0; q < 2; ++q) {
            const int j = lane + 64 * q;
            float ps = 0.f;
#pragma unroll
            for (int e = -1; e <= 3; ++e) {
                const int c = 4 * j + e;
                if (c >= 0 && c < NCMP) { const float im = (pc[c] + pc[512 + c]) + (pc[1024 + c] + pc[1536 + c]); ps += (e == -1 || e == 3) ? im : 2.f * im; }
            }
            const int cur = t >> 6;
            const bool ok = (j * 64) <= t, forced = (j == 0) || (j == cur) || (j == cur - 1);
            sc[q] = ok ? ps + (forced ? 1e4f : 0.f) : -1e30f;
        }
        for (int it = 0; it < 16; ++it) {
            float bv; int bi;
            if (sc[0] >= sc[1]) { bv = sc[0]; bi = lane; } else { bv = sc[1]; bi = lane + 64; }
#pragma unroll
            for (int o = 1; o < 64; o <<= 1) {
                const float ov = __shfl_xor(bv, o); const int oi = __shfl_xor(bi, o);
                if (ov > bv || (ov == bv && oi < bi)) { bv = ov; bi = oi; }
            }
            if (lane == 0) sel[it] = bi;
            if (bi == lane) sc[0] = -3e38f;
            if (bi == lane + 64) sc[1] = -3e38f;
        }
        WAVE_SYNC();
    }
    float obr[2][4];
#pragma unroll
    for (int br = 0; br < 2; ++br) {
        float m[4] = {-1e30f, -1e30f, -1e30f, -1e30f}, lsum[4] = {0.f, 0.f, 0.f, 0.f}, o[4] = {0.f, 0.f, 0.f, 0.f};
        const int kcol = ZC_NKV + (br ? 4 : 2) * 128 + g * 64, vcol = kcol + 128;
        const int nblk = br ? 8 : 16;
        for (int ib = 0; ib < nblk; ++ib) {
            const int p0 = br ? (t - 511 + 64 * ib) : sel[ib] * 64;
            if (p0 > t || p0 + 63 < 0) continue;
            const int pos = p0 + lane;
            const bool valid = pos >= 0 && pos <= t;
            float s4[4] = {0.f, 0.f, 0.f, 0.f};
            if (valid) {
                const bf16_t* kr = Z + (size_t)(b * SEQ + pos) * ZLD + kcol;
                for (int d = 0; d < 64; d += 4) {
                    const ushort4 k4 = *(const ushort4*)(kr + d);
                    const float k0 = bf2f(k4.x), k1 = bf2f(k4.y), k2 = bf2f(k4.z), k3 = bf2f(k4.w);
#pragma unroll
                    for (int r = 0; r < 4; ++r) s4[r] += qs[r * 64 + d] * k0 + qs[r * 64 + d + 1] * k1 + qs[r * 64 + d + 2] * k2 + qs[r * 64 + d + 3] * k3;
                }
                const int dist = min(t - pos, 1023);
#pragma unroll
                for (int r = 0; r < 4; ++r) s4[r] = s4[r] * 0.125f + bt_g[r * 1024 + dist];
            }
            float f[4];
#pragma unroll
            for (int r = 0; r < 4; ++r) {
                const float mb = wave_max(valid ? s4[r] : -1e30f);
                const float mn = fmaxf(m[r], mb);
                f[r] = expf(m[r] - mn);
                const float e = valid ? expf(s4[r] - mn) : 0.f;
                lsum[r] = lsum[r] * f[r] + wave_sum(e);
                m[r] = mn;
                pl[r * 64 + lane] = e;
                o[r] *= f[r];
            }
            WAVE_SYNC();
            const int klo = max(0, -p0), khi = min(63, t - p0);
            for (int k = klo; k <= khi; ++k) {
                const float v = bf2f(Z[(size_t)(b * SEQ + p0 + k) * ZLD + vcol + lane]);
                o[0] += pl[k] * v; o[1] += pl[64 + k] * v; o[2] += pl[128 + k] * v; o[3] += pl[192 + k] * v;
            }
            WAVE_SYNC();
        }
#pragma unroll
        for (int r = 0; r < 4; ++r) obr[br][r] = o[r] / fmaxf(lsum[r], 1e-30f);
    }
#pragma unroll
    for (int r = 0; r < 4; ++r) {
        const bf16_t* gp = zrow + ZC_NG + g * 12 + r * 3;
        const float g0 = sigmoidf_(bf2f(gp[0])), g1 = sigmoidf_(bf2f(gp[1])), g2 = sigmoidf_(bf2f(gp[2]));
        Y[(size_t)bt * DM + 512 + g * 256 + r * 64 + lane] = f2bf(g0 * ocmp[r] + g1 * obr[0][r] + g2 * obr[1][r]);
    }
    WAVE_SYNC();
}

__device__ __forceinline__ void final_norm(float* X, const float* ssq, const float* gain, int bid, int nb) {
    const int wave = tidx() >> 6, lane = tidx() & 63;
    for (int r = bid * NWAVE + wave; r < MTOK; r += nb * NWAVE) {
        const float rs = rstd_of(ssq, r);
#pragma unroll
        for (int j = 0; j < 4; ++j) {
            f32x4* px = (f32x4*)(X + (size_t)r * DM + j * 256 + lane * 4);
            const f32x4 gv = *(const f32x4*)(gain + j * 256 + lane * 4);
            f32x4 v = *px; v.x *= rs * gv.x; v.y *= rs * gv.y; v.z *= rs * gv.z; v.w *= rs * gv.w; *px = v;
        }
    }
}

namespace hg {
typedef short bf16x8 __attribute__((ext_vector_type(8)));
typedef unsigned u32x4 __attribute__((ext_vector_type(4)));
constexpr int LDP = 72;
constexpr int OFF_KT = 0, OFF_VT = 9216, OFF_QH = 18432, OFF_QT = 27648, OFF_KV = 36864, OFF_AM = 59904, OFF_O = 69120, OFF_SEG = 86528, HG_LDS = 88576;
__device__ __forceinline__ unsigned pk2(float lo, float hi) { return pg8::cvt_pk_bf16(lo, hi); }
__device__ __forceinline__ bf16x8 ldsfrag(const unsigned char* base, int row, int col) { return *(const bf16x8*)(base + (row * LDP + col) * 2); }

__device__ __forceinline__ void prep(const bf16_t* Z, int item, float lbv, float (&bb)[8], float (&kk)[8], float (&qq)[8], float (&vv)[8],
                                     float& tot, float& r1, float& r2, float& r3, float* seg_lds) {
    const int d = tidx() & 63, seg = tidx() >> 6;
    const int bh = item >> 7, c = item & 127, b_ = bh >> 2, h = bh & 3;
    const bf16_t* zp = Z + (size_t)(b_ * SEQ + c * 64 + seg * 8) * ZLD + h * 64 + d;
    float run = 0.f;
#pragma unroll
    for (int j = 0; j < 8; ++j) {
        const float q = bf2f(zp[(size_t)j * ZLD + ZC_HQ]), fl = bf2f(zp[(size_t)j * ZLD + ZC_HF]), iv = bf2f(zp[(size_t)j * ZLD + ZC_HI]);
        const float e = __expf(-fabsf(fl)), inv = 1.f / (1.f + e);
        const float sig = fl >= 0.f ? inv : e * inv, sigm = fl >= 0.f ? e * inv : inv;
        const float f = lbv + (1.f - lbv) * sig;
        run += __logf(fmaxf(f, 1e-30f));
        bb[j] = run; kk[j] = (1.f - lbv) * sigm; qq[j] = q / (1.f + __expf(-q)); vv[j] = iv;
    }
    seg_lds[seg * 64 + d] = run;
    __syncthreads();
    float pre = 0.f, off = 0.f; r1 = 0.f; r2 = 0.f; r3 = 0.f;
#pragma unroll
    for (int i = 0; i < 8; ++i) {
        if (i == 2) r1 = pre; if (i == 4) r2 = pre; if (i == 6) r3 = pre;
        if (i == seg) off = pre;
        pre += seg_lds[i * 64 + d];
    }
    tot = pre;
#pragma unroll
    for (int j = 0; j < 8; ++j) bb[j] += off;
}

__device__ __forceinline__ void phase1(const bf16_t* Z, const float* LBl, float* DS, float* GAM, unsigned char* lds, int item) {
    const int tid = tidx(), lane = tid & 63, wave = tid >> 6, d = lane, seg = wave;
    const int h = (item >> 7) & 3;
    float bb[8], kk[8], qq[8], vv[8], tot, r1, r2, r3;
    prep(Z, item, LBl[h * 64 + d], bb, kk, qq, vv, tot, r1, r2, r3, (float*)(lds + OFF_SEG));
    {
        float kh[8];
#pragma unroll
        for (int j = 0; j < 8; ++j) kh[j] = kk[j] * __expf(tot - bb[j]);
        u32x4 w; w.x = pk2(kh[0], kh[1]); w.y = pk2(kh[2], kh[3]); w.z = pk2(kh[4], kh[5]); w.w = pk2(kh[6], kh[7]);
        *(u32x4*)(lds + OFF_KT + (d * LDP + 8 * seg) * 2) = w;
        u32x4 v; v.x = pk2(vv[0], vv[1]); v.y = pk2(vv[2], vv[3]); v.z = pk2(vv[4], vv[5]); v.w = pk2(vv[6], vv[7]);
        *(u32x4*)(lds + OFF_VT + (d * LDP + 8 * seg) * 2) = v;
        if (seg == 0) GAM[(size_t)item * 64 + d] = __expf(tot);
    }
    __syncthreads();
    const int row = lane & 15, kq = lane >> 4, mt = wave >> 1;
#pragma unroll
    for (int q = 0; q < 2; ++q) {
        const int nt = (wave & 1) * 2 + q;
        f32x4 acc = (f32x4){0.f, 0.f, 0.f, 0.f};
#pragma unroll
        for (int ks = 0; ks < 2; ++ks) {
            const bf16x8 a = ldsfrag(lds + OFF_VT, 16 * mt + row, 32 * ks + 8 * kq);
            const bf16x8 bq = ldsfrag(lds + OFF_KT, 16 * nt + row, 32 * ks + 8 * kq);
            acc = __builtin_amdgcn_mfma_f32_16x16x32_bf16(a, bq, acc, 0, 0, 0);
        }
        float* o = DS + (size_t)item * 4096 + (16 * mt + 4 * kq) * 64 + 16 * nt + row;
#pragma unroll
        for (int r = 0; r < 4; ++r) o[r * 64] = acc[r];
    }
    __syncthreads();
}

__device__ __forceinline__ void phase2(const float* DS, const float* GAM, bf16_t* ST, int idx  ) {
    const int bh = idx >> 12, ed = idx & 4095, d = ed & 63;
    float S = 0.f;
    for (int c0 = 0; c0 < 128; c0 += 32) {
        float ds[32], gm[32];
#pragma unroll
        for (int j = 0; j < 32; ++j) { ds[j] = DS[(size_t)(bh * 128 + c0 + j) * 4096 + ed]; gm[j] = GAM[(size_t)(bh * 128 + c0 + j) * 64 + d]; }
#pragma unroll
        for (int j = 0; j < 32; ++j) { ST[(size_t)(bh * 128 + c0 + j) * 4096 + ed] = f2bf(S); S = gm[j] * S + ds[j]; }
    }
}

__device__ __forceinline__ void phase3(const bf16_t* Z, const float* LBl, const float* gain, const bf16_t* ST, bf16_t* Y, unsigned char* lds, int item) {
    const int tid = tidx(), lane = tid & 63, wave = tid >> 6, d = lane, seg = wave;
    const int bh = item >> 7, c = item & 127, b_ = bh >> 2, h = bh & 3;
    float bb[8], kk[8], qq[8], vv[8], tot, r1, r2, r3;
    prep(Z, item, LBl[h * 64 + d], bb, kk, qq, vv, tot, r1, r2, r3, (float*)(lds + OFF_SEG));
    {
        u32x4 v; v.x = pk2(vv[0], vv[1]); v.y = pk2(vv[2], vv[3]); v.z = pk2(vv[4], vv[5]); v.w = pk2(vv[6], vv[7]);
        *(u32x4*)(lds + OFF_VT + (d * LDP + 8 * seg) * 2) = v;
        const int it = seg >> 1;
        const float rr[4] = {0.f, r1, r2, r3};
        const float rmine = it == 0 ? 0.f : (it == 1 ? r1 : (it == 2 ? r2 : r3));
        bf16_t* QH = (bf16_t*)(lds + OFF_QH); bf16_t* QT = (bf16_t*)(lds + OFF_QT); bf16_t* KV = (bf16_t*)(lds + OFF_KV);
#pragma unroll
        for (int j = 0; j < 8; ++j) {
            const int t = 8 * seg + j;
            QH[t * LDP + d] = f2bf(qq[j] * __expf(bb[j]));
            QT[t * LDP + d] = f2bf(qq[j] * __expf(bb[j] - rmine));
#pragma unroll
            for (int i = 0; i < 4; ++i) {
                const int base = (i == 0) ? 0 : (i == 1 ? 16 : (i == 2 ? 48 : 96));
                if (i >= it) KV[(base + t) * LDP + d] = f2bf(kk[j] * __expf(rr[i] - bb[j]));
            }
        }
        bf16_t* AM = (bf16_t*)(lds + OFF_AM);
        { const int blk = tid >> 8, e = tid & 255, r = e >> 4, cc = e & 15; AM[(32 * blk + r) * LDP + 16 + 32 * blk + cc] = 0; }
    }
    __syncthreads();
    const int row = lane & 15, kq = lane >> 4;
    {
        bf16_t* AM = (bf16_t*)(lds + OFF_AM);
#pragma unroll
        for (int rep = 0; rep < 2; ++rep) {
            const int blk = wave + 8 * rep;
            if (blk < 10) {
                const int i = blk == 0 ? 0 : (blk < 3 ? 1 : (blk < 6 ? 2 : 3));
                const int j = blk - (i == 0 ? 0 : (i == 1 ? 1 : (i == 2 ? 3 : 6)));
                const int base = (i == 0) ? 0 : (i == 1 ? 16 : (i == 2 ? 48 : 96));
                f32x4 acc = (f32x4){0.f, 0.f, 0.f, 0.f};
#pragma unroll
                for (int ks = 0; ks < 2; ++ks) {
                    const bf16x8 a = ldsfrag(lds + OFF_QT, 16 * i + row, 32 * ks + 8 * kq);
                    const bf16x8 bq = ldsfrag(lds + OFF_KV, base + 16 * j + row, 32 * ks + 8 * kq);
                    acc = __builtin_amdgcn_mfma_f32_16x16x32_bf16(a, bq, acc, 0, 0, 0);
                }
#pragma unroll
                for (int r = 0; r < 4; ++r) {
                    const int tl = 4 * kq + r, sl = row;
                    const float v = (i == j && sl > tl) ? 0.f : acc[r];
                    AM[(16 * i + tl) * LDP + 16 * j + sl] = f2bf(v);
                }
            }
        }
    }
    __syncthreads();
    {
        const int mt = wave >> 1;
        float* O = (float*)(lds + OFF_O);
        const bf16_t* Sg = ST + (size_t)item * 4096;
#pragma unroll
        for (int q = 0; q < 2; ++q) {
            const int nt = (wave & 1) * 2 + q;
            f32x4 acc = (f32x4){0.f, 0.f, 0.f, 0.f};
#pragma unroll
            for (int ks = 0; ks < 2; ++ks) {
                if (ks <= (mt >> 1)) {
                    const bf16x8 a = ldsfrag(lds + OFF_AM, 16 * mt + row, 32 * ks + 8 * kq);
                    const bf16x8 bq = ldsfrag(lds + OFF_VT, 16 * nt + row, 32 * ks + 8 * kq);
                    acc = __builtin_amdgcn_mfma_f32_16x16x32_bf16(a, bq, acc, 0, 0, 0);
                }
            }
#pragma unroll
            for (int ks = 0; ks < 2; ++ks) {
                const bf16x8 a = ldsfrag(lds + OFF_QH, 16 * mt + row, 32 * ks + 8 * kq);
                const bf16x8 bq = *(const bf16x8*)(Sg + (16 * nt + row) * 64 + 32 * ks + 8 * kq);
                acc = __builtin_amdgcn_mfma_f32_16x16x32_bf16(a, bq, acc, 0, 0, 0);
            }
#pragma unroll
            for (int r = 0; r < 4; ++r) O[(16 * mt + 4 * kq + r) * 68 + 16 * nt + row] = acc[r];
        }
    }
    __syncthreads();
    {
        const int t = tid >> 3, e0 = (tid & 7) * 8;
        const float* O = (const float*)(lds + OFF_O) + t * 68 + e0;
        const f32x4 o0 = *(const f32x4*)O, o1 = *(const f32x4*)(O + 4);
        float ss = ((o0[0] * o0[0] + o0[1] * o0[1]) + (o0[2] * o0[2] + o0[3] * o0[3])) + ((o1[0] * o1[0] + o1[1] * o1[1]) + (o1[2] * o1[2] + o1[3] * o1[3]));
        ss += __shfl_xor(ss, 1); ss += __shfl_xor(ss, 2); ss += __shfl_xor(ss, 4);
        const float rs = rsqrtf(ss * (1.f / 64.f) + EPS);
        const size_t tok = (size_t)(b_ * SEQ + c * 64 + t);
        const u32x4 gw = *(const u32x4*)(Z + tok * ZLD + ZC_HG + h * 64 + e0);
        const f32x4 g0 = *(const f32x4*)(gain + e0), g1 = *(const f32x4*)(gain + e0 + 4);
        float ov[8] = {o0[0], o0[1], o0[2], o0[3], o1[0], o1[1], o1[2], o1[3]};
        const float gn[8] = {g0[0], g0[1], g0[2], g0[3], g1[0], g1[1], g1[2], g1[3]};
        const unsigned gwv[4] = {gw.x, gw.y, gw.z, gw.w};
#pragma unroll
        for (int j = 0; j < 8; ++j) {
            const float gv = __uint_as_float((j & 1) ? (gwv[j >> 1] & 0xffff0000u) : (gwv[j >> 1] << 16));
            ov[j] = ov[j] * rs * gn[j] * (gv / (1.f + __expf(-gv)));
        }
        u32x4 w; w.x = pk2(ov[0], ov[1]); w.y = pk2(ov[2], ov[3]); w.z = pk2(ov[4], ov[5]); w.w = pk2(ov[6], ov[7]);
        *(u32x4*)(Y + tok * DM + 256 + h * 64 + e0) = w;
    }
    __syncthreads();
}
}

namespace s5 {
typedef short bf16x8 __attribute__((ext_vector_type(8)));
typedef unsigned u32x4 __attribute__((ext_vector_type(4)));
typedef unsigned u32x2 __attribute__((ext_vector_type(2)));
constexpr size_t T_KT = 0, T_A1 = 532480, T_A2 = T_A1 + 4194304, T_LAYER = T_A2 + 4194304;
constexpr int UPITCH = 2064;
constexpr int OFF_U = 0, OFF_KT = 16 * UPITCH  , S5_LDS = OFF_KT + 65 * 512;

__device__ __forceinline__ void pow_table(const Params& p, float* POW, int gtid, int gthreads) {
    for (int i = gtid; i < 2 * 16 * 65 * 64; i += gthreads) {
        const int pp = i & 63, j = (i >> 6) % 65, lg = i / (65 * 64), g = lg & 15, l = lg >> 4, gp = g * 64 + pp;
        const double lr = (double)p.in[8][l * 1024 + gp], li = (double)p.in[9][l * 1024 + gp], dt = exp((double)p.in[10][l * 16 + g]);
        const double mag = exp(lr * dt * (double)j), ang = li * dt * (double)j;
        POW[2 * (size_t)i] = (float)(mag * cos(ang)); POW[2 * (size_t)i + 1] = (float)(mag * sin(ang));
    }
}
__device__ __forceinline__ void build_tables(const Params& p, int l, const float* POW, const float* tab, unsigned char* T, int gtid, int gthreads) {
    const float2* powl = (const float2*)POW + (size_t)l * 16 * 65 * 64;
    const float* bbr = tab + 2048; const float* bbi = tab + 2048 + 16384;
    const float* c_re = p.in[13] + l * 16384; const float* c_im = p.in[14] + l * 16384;
    bf16_t* KT = (bf16_t*)(T + T_KT); bf16_t* A1 = (bf16_t*)(T + T_A1); bf16_t* A2 = (bf16_t*)(T + T_A2);
    for (int i = gtid; i < 16 * 65 * 256; i += gthreads) {
        const int hi = i & 15, ho = (i >> 4) & 15, li = (i >> 8) % 65, g = i / (65 * 256);
        float acc = 0.f;
        if (li > 0) {
            const float2* pw = powl + (size_t)(g * 65 + li - 1) * 64;
            const float* cr = c_re + (g * 16 + ho) * 64; const float* ci = c_im + (g * 16 + ho) * 64;
#pragma unroll 8
            for (int pp = 0; pp < 64; ++pp) {
                const float2 pq = pw[pp];
                const float br = bbr[(g * 64 + pp) * 16 + hi], bi = bbi[(g * 64 + pp) * 16 + hi];
                acc += cr[pp] * (pq.x * br - pq.y * bi) - ci[pp] * (pq.x * bi + pq.y * br);
            }
        }
        KT[i] = f2bf(acc);
    }
    for (int i = gtid; i < 16 * 64 * 64 * 8; i += gthreads) {
        const int hp = i & 7, s = (i >> 3) & 63, pp = (i >> 9) & 63, g = i >> 15, gp = g * 64 + pp;
        const float2 pq = powl[(size_t)(g * 65 + 63 - s) * 64 + pp];
        const float br0 = bbr[gp * 16 + 2 * hp], bi0 = bbi[gp * 16 + 2 * hp], br1 = bbr[gp * 16 + 2 * hp + 1], bi1 = bbi[gp * 16 + 2 * hp + 1];
        unsigned* o0 = (unsigned*)(A1 + ((size_t)(g * 128 + 2 * pp) * 1024 + s * 16 + 2 * hp));
        o0[0] = pg8::cvt_pk_bf16(pq.x * br0 - pq.y * bi0, pq.x * br1 - pq.y * bi1);
        o0[512] = pg8::cvt_pk_bf16(pq.x * bi0 + pq.y * br0, pq.x * bi1 + pq.y * br1);
    }
    for (int i = gtid; i < 16 * 64 * 16 * 64; i += gthreads) {
        const int pp = i & 63, ho = (i >> 6) & 15, t = (i >> 10) & 63, g = i >> 16;
        const float2 pq = powl[(size_t)(g * 65 + t + 1) * 64 + pp];
        const float cr = c_re[(g * 16 + ho) * 64 + pp], ci = c_im[(g * 16 + ho) * 64 + pp];
        *(unsigned*)(A2 + ((size_t)(g * 1024 + t * 16 + ho) * 128 + 2 * pp)) = pg8::cvt_pk_bf16(cr * pq.x - ci * pq.y, -(cr * pq.y + ci * pq.x));
    }
}
__device__ __forceinline__ void stage_u(const bf16_t* Z, int g, int b_, int cgrp, unsigned char* lds) {
#pragma unroll
    for (int q = 0; q < 4; ++q) {
        const int i = tidx() + 512 * q, n = i >> 7, s = (i >> 1) & 63, half = i & 1;
        const u32x4 v = *(const u32x4*)(Z + (size_t)(b_ * SEQ + (cgrp * 16 + n) * 64 + s) * ZLD + ZC_U + g * 16 + 8 * half);
        *(u32x4*)(lds + OFF_U + n * UPITCH + s * 32 + half * 16) = v;
    }
}
__device__ __forceinline__ bf16x8 ufrag(const unsigned char* lds, int n, int ks, int kq) { return *(const bf16x8*)(lds + OFF_U + n * UPITCH + (2 * ks + (kq >> 1)) * 32 + (kq & 1) * 16); }

__device__ __forceinline__ void phase1(const bf16_t* Z, const unsigned char* T, float* XE, unsigned char* lds, int item) {
    const int lane = tidx() & 63, wave = tidx() >> 6, row = lane & 15, kq = lane >> 4;
    const int g = item >> 4, b_ = (item >> 3) & 1, cgrp = item & 7;
    stage_u(Z, g, b_, cgrp, lds);
    __syncthreads();
    const bf16_t* A1 = (const bf16_t*)(T + T_A1) + (size_t)(g * 128 + 16 * wave + row) * 1024 + 8 * kq;
    f32x4 acc = (f32x4){0.f, 0.f, 0.f, 0.f};
#pragma unroll 8
    for (int ks = 0; ks < 32; ++ks) {
        const bf16x8 a = *(const bf16x8*)(A1 + 32 * ks);
        acc = __builtin_amdgcn_mfma_f32_16x16x32_bf16(a, ufrag(lds, row, ks, kq), acc, 0, 0, 0);
    }
    *(f32x4*)(XE + ((size_t)((b_ * 16 + g) * 128 + cgrp * 16 + row)) * 128 + 16 * wave + 4 * kq) = acc;
    __syncthreads();
}
__device__ __forceinline__ void phase2(const float* XE, const float* A64l  , bf16_t* XC, int idx  ) {
    const int bg = idx >> 6, pp = idx & 63, g = bg & 15;
    const float ar = A64l[(g * 64 + pp) * 2], ai = A64l[(g * 64 + pp) * 2 + 1];
    float xr = 0.f, xi = 0.f;
    for (int c0 = 0; c0 < 128; c0 += 16) {
        float er[16], ei[16];
#pragma unroll
        for (int j = 0; j < 16; ++j) { const float2 e = *(const float2*)(XE + ((size_t)(bg * 128 + c0 + j)) * 128 + 2 * pp); er[j] = e.x; ei[j] = e.y; }
#pragma unroll
        for (int j = 0; j < 16; ++j) {
            *(unsigned*)(XC + ((size_t)(bg * 128 + c0 + j)) * 128 + 2 * pp) = pg8::cvt_pk_bf16(xr, xi);
            const float nr = ar * xr - ai * xi + er[j], ni = ar * xi + ai * xr + ei[j];
            xr = nr; xi = ni;
        }
    }
}
__device__ __forceinline__ void phase3(const Params& p, int l, const bf16_t* Z, const unsigned char* T, const bf16_t* XC, bf16_t* Y, unsigned char* lds, int item) {
    const int tid = tidx(), lane = tid & 63, wave = tid >> 6, row = lane & 15, kq = lane >> 4;
    const int g = item >> 4, b_ = (item >> 3) & 1, cgrp = item & 7;
    stage_u(Z, g, b_, cgrp, lds);
    {
        const u32x4* src = (const u32x4*)(T + T_KT + (size_t)g * 65 * 512);
        for (int i = tid; i < 65 * 32; i += NT) *(u32x4*)(lds + OFF_KT + i * 16) = src[i];
    }
    __syncthreads();
    const bf16_t* xcp = XC + ((size_t)((b_ * 16 + g) * 128 + cgrp * 16 + row)) * 128 + 8 * kq;
    bf16x8 xc[4];
#pragma unroll
    for (int ks = 0; ks < 4; ++ks) xc[ks] = *(const bf16x8*)(xcp + 32 * ks);
    const float* dsk = p.in[15] + l * 256 + g * 16 + 4 * kq;
    const f32x4 dv = *(const f32x4*)dsk;
    for (int q = 0; q < 8; ++q) {
        const int t = 8 * q + ((q & 1) ? (7 - wave) : wave);
        f32x4 acc = (f32x4){0.f, 0.f, 0.f, 0.f};
        const bf16_t* A2 = (const bf16_t*)(T + T_A2) + (size_t)(g * 1024 + t * 16 + row) * 128 + 8 * kq;
#pragma unroll
        for (int ks = 0; ks < 4; ++ks) acc = __builtin_amdgcn_mfma_f32_16x16x32_bf16(*(const bf16x8*)(A2 + 32 * ks), xc[ks], acc, 0, 0, 0);
        const int nks = (t >> 1) + 1;
        for (int ks = 0; ks < nks; ++ks) {
            const int s = 2 * ks + (kq >> 1), li = t - s + 1;
            const bf16x8 a = *(const bf16x8*)(lds + OFF_KT + ((li * 16 + row) * 16 + 8 * (kq & 1)) * 2);
            acc = __builtin_amdgcn_mfma_f32_16x16x32_bf16(a, ufrag(lds, row, ks, kq), acc, 0, 0, 0);
        }
        const size_t tok = (size_t)(b_ * SEQ + (cgrp * 16 + row) * 64 + t);
        const u32x2 uw = *(const u32x2*)(Z + tok * ZLD + ZC_U + g * 16 + 4 * kq);
        const float u0 = __uint_as_float(uw.x << 16), u1 = __uint_as_float(uw.x & 0xffff0000u), u2 = __uint_as_float(uw.y << 16), u3 = __uint_as_float(uw.y & 0xffff0000u);
        const float y0 = gelu_tanh(acc[0] + dv[0] * u0), y1 = gelu_tanh(acc[1] + dv[1] * u1), y2 = gelu_tanh(acc[2] + dv[2] * u2), y3 = gelu_tanh(acc[3] + dv[3] * u3);
        u32x2 w; w.x = pg8::cvt_pk_bf16(y0, y1); w.y = pg8::cvt_pk_bf16(y2, y3);
        *(u32x2*)(Y + tok * DM + g * 16 + 4 * kq) = w;
    }
    __syncthreads();
}
}
namespace pg8 {
struct EpiGLU {
    static constexpr bool PERM = true, AFTER_DRAIN = false;
    bf16_t* Y;
    __device__ __forceinline__ void operator()(const f32x4 (&acc)[2][2][4][2], const Unit& u, int wr, int wc, int fr, int fq) const {
#pragma unroll
        for (int ai = 0; ai < 2; ++ai)
#pragma unroll
            for (int m = 0; m < 4; ++m) {
                const int row = u.pm * BM + ai * HALF + wr * 64 + m * 16 + fr;
#pragma unroll
                for (int bj = 0; bj < 2; ++bj) {
                    const int col0 = u.pn * BM + bj * HALF + wc * 32 + 8 * fq;
                    u32x4* py = (u32x4*)(Y + (size_t)row * 1024 + col0);
                    const u32x4 yw = *py;
                    const unsigned ywv[4] = {yw.x, yw.y, yw.z, yw.w};
                    float o[8];
#pragma unroll
                    for (int j = 0; j < 8; ++j) {
                        const float yv = __uint_as_float((j & 1) ? (ywv[j >> 1] & 0xffff0000u) : (ywv[j >> 1] << 16));
                        const float a = acc[ai][bj][m][j >> 2][j & 3];
                        o[j] = yv * __builtin_amdgcn_rcpf(1.0f + __builtin_amdgcn_exp2f(-1.4426950408889634f * a));
                    }
                    u32x4 w; w.x = cvt_pk_bf16(o[0], o[1]); w.y = cvt_pk_bf16(o[2], o[3]); w.z = cvt_pk_bf16(o[4], o[5]); w.w = cvt_pk_bf16(o[6], o[7]);
                    *py = w;
                }
            }
    }
};
}

__device__ __forceinline__ void nsa_slc_naive(const bf16_t* Z, const unsigned* SELMASK, bf16_t* Y, const float* btab, float* lw, int item) {
    const int lane = tidx() & 63;
    const int g = item & 1, bt = item >> 1, b = bt / SEQ, t = bt % SEQ;
    float* qs = lw; float* pl = lw + 256;
    const bf16_t* zrow = Z + (size_t)bt * ZLD;
#pragma unroll
    for (int r = 0; r < 4; ++r) qs[r * 64 + lane] = bf2f(zrow[ZC_NQ + g * 256 + r * 64 + lane]);
    WAVE_SYNC();
    const float* bt_g = btab + (g * 4) * 1024;
    const unsigned* mk = SELMASK + ((size_t)(b * 2 + g) * SEQ + t) * 4;
    float m[4] = {-1e30f, -1e30f, -1e30f, -1e30f}, lsum[4] = {0.f, 0.f, 0.f, 0.f}, o[4] = {0.f, 0.f, 0.f, 0.f};
    const int kcol = ZC_NKV + 2 * 128 + g * 64, vcol = kcol + 128;
    for (int jb = 0; jb * 64 <= t; ++jb) {
        if (!((mk[jb >> 5] >> (jb & 31)) & 1u)) continue;
        const int p0 = jb * 64, pos = p0 + lane;
        const bool valid = pos <= t;
        float s4[4] = {0.f, 0.f, 0.f, 0.f};
        if (valid) {
            const bf16_t* kr = Z + (size_t)(b * SEQ + pos) * ZLD + kcol;
            for (int d = 0; d < 64; d += 4) {
                const ushort4 k4 = *(const ushort4*)(kr + d);
                const float k0 = bf2f(k4.x), k1 = bf2f(k4.y), k2 = bf2f(k4.z), k3 = bf2f(k4.w);
#pragma unroll
                for (int r = 0; r < 4; ++r) s4[r] += qs[r * 64 + d] * k0 + qs[r * 64 + d + 1] * k1 + qs[r * 64 + d + 2] * k2 + qs[r * 64 + d + 3] * k3;
            }
            const int dist = min(t - pos, 1023);
#pragma unroll
            for (int r = 0; r < 4; ++r) s4[r] = s4[r] * 0.125f + bt_g[r * 1024 + dist];
        }
#pragma unroll
        for (int r = 0; r < 4; ++r) {
            const float mb = wave_max(valid ? s4[r] : -1e30f);
            const float mn = fmaxf(m[r], mb);
            const float f = expf(m[r] - mn);
            const float e = valid ? expf(s4[r] - mn) : 0.f;
            lsum[r] = lsum[r] * f + wave_sum(e);
            m[r] = mn; pl[r * 64 + lane] = e; o[r] *= f;
        }
        WAVE_SYNC();
        const int khi = min(63, t - p0);
        for (int k = 0; k <= khi; ++k) {
            const float v = bf2f(Z[(size_t)(b * SEQ + p0 + k) * ZLD + vcol + lane]);
            o[0] += pl[k] * v; o[1] += pl[64 + k] * v; o[2] += pl[128 + k] * v; o[3] += pl[192 + k] * v;
        }
        WAVE_SYNC();
    }
#pragma unroll
    for (int r = 0; r < 4; ++r) {
        const float g1 = sigmoidf_(bf2f(zrow[ZC_NG + g * 12 + r * 3 + 1]));
        bf16_t* yp = Y + (size_t)bt * DM + 512 + g * 256 + r * 64 + lane;
        *yp = f2bf(bf2f(*yp) + g1 * o[r] / fmaxf(lsum[r], 1e-30f));
    }
    WAVE_SYNC();
}
namespace nsa {
typedef short bf16x8 __attribute__((ext_vector_type(8)));
typedef short s16x4 __attribute__((ext_vector_type(4)));
typedef float f32x16 __attribute__((ext_vector_type(16)));
typedef unsigned u32x4 __attribute__((ext_vector_type(4)));
#define NSA_LAS __attribute__((address_space(3)))
constexpr int KP = 72;
constexpr float LOG2E = 1.4426950408889634f, QSCALE = 0.125f * LOG2E, THR = 8.0f;
constexpr int TILE_B = 64 * KP * 2;
constexpr int BTP = 1040;
constexpr int OFF_BT = 0, OFF_K = 8 * BTP * 4, OFF_V = OFF_K + 2 * TILE_B, OFF_WS = OFF_V + 2 * TILE_B, WS_PER_WAVE = 256 + 8192, NSA_LDS = OFF_WS + 8 * WS_PER_WAVE;
static_assert(NSA_LDS <= LDS_BYTES, "nsa lds");
__device__ __forceinline__ int crow(int i, int h) { return (i & 3) + 8 * (i >> 2) + 4 * h; }
__device__ __forceinline__ float dpp_xor1(float v) { return __int_as_float(__builtin_amdgcn_update_dpp(0, __float_as_int(v), 0xB1, 0xF, 0xF, true)); }
__device__ __forceinline__ float dpp_xor2(float v) { return __int_as_float(__builtin_amdgcn_update_dpp(0, __float_as_int(v), 0x4E, 0xF, 0xF, true)); }
#define NSA_LWAIT() asm volatile("s_waitcnt lgkmcnt(0)" ::: "memory")
__device__ __forceinline__ float dpp_hmir(float v) { return __int_as_float(__builtin_amdgcn_update_dpp(0, __float_as_int(v), 0x141, 0xF, 0xF, true)); }
__device__ __forceinline__ int dppi_xor1(int v) { return __builtin_amdgcn_update_dpp(0, v, 0xB1, 0xF, 0xF, true); }
__device__ __forceinline__ int dppi_xor2(int v) { return __builtin_amdgcn_update_dpp(0, v, 0x4E, 0xF, 0xF, true); }
__device__ __forceinline__ int dppi_hmir(int v) { return __builtin_amdgcn_update_dpp(0, v, 0x141, 0xF, 0xF, true); }
__device__ __forceinline__ float swapadd(float v) {
    auto rr = __builtin_amdgcn_permlane32_swap(__float_as_uint(v), __float_as_uint(v), false, false);
    return __uint_as_float(rr[0]) + __uint_as_float(rr[1]);
}

__device__ __forceinline__ void fill_btab(const float* rel_bias, unsigned char* lds) {
    float* bt = (float*)(lds + OFF_BT);
    for (int i = tidx(); i < 8192; i += NT) { const int hh = i >> 10, d = i & 1023; bt[hh * BTP + d] = rel_bias[t5_bucket(d) * 8 + hh] * LOG2E; }
}
struct TileRegs { u32x4 k, v; };
__device__ __forceinline__ void tile_load(TileRegs& r, const bf16_t* kb, const bf16_t* vb, unsigned pitch, int r0) {
    const unsigned off = (unsigned)(r0 + (tidx() >> 3)) * pitch + (tidx() & 7) * 8;
    r.k = *(const u32x4*)(kb + off); r.v = *(const u32x4*)(vb + off);
}
__device__ __forceinline__ void tile_store(unsigned char* lds, int buf, const TileRegs& r) {
    const int o = ((tidx() >> 3) * KP + (tidx() & 7) * 8) * 2;
    *(u32x4*)(lds + OFF_K + buf * TILE_B + o) = r.k; *(u32x4*)(lds + OFF_V + buf * TILE_B + o) = r.v;
}
typedef NSA_LAS const unsigned char* ldsp;
__device__ __forceinline__ f32x16 qk32(ldsp Kl, const bf16x8 (&qf)[4], f32x16 c, int r32, int h) {
#pragma unroll
    for (int ks = 0; ks < 4; ++ks) {
        const bf16x8 kf = *(NSA_LAS const bf16x8*)(Kl + 32 * ks);
        c = __builtin_amdgcn_mfma_f32_32x32x16_bf16(kf, qf[ks], c, 0, 0, 0);
    }
    return c;
}
__device__ __forceinline__ s16x4 trread(ldsp p) { return __builtin_bit_cast(s16x4, __builtin_amdgcn_ds_read_tr16_b64_v4i16((NSA_LAS s16x4*)p)); }
__device__ __forceinline__ void pv32(f32x16 (&o)[2], ldsp Vl, const bf16x8 (&pf)[2], int lane) {
#pragma unroll
    for (int dt = 0; dt < 2; ++dt)
#pragma unroll
        for (int s = 0; s < 2; ++s) {
            ldsp a0 = Vl + (16 * s * KP + 32 * dt) * 2;
            const s16x4 lo = trread(a0), hi = trread(a0 + 8 * KP * 2);
            const bf16x8 vf = (bf16x8){lo[0], lo[1], lo[2], lo[3], hi[0], hi[1], hi[2], hi[3]};
            o[dt] = __builtin_amdgcn_mfma_f32_32x32x16_bf16(pf[s], vf, o[dt], 0, 0, 0);
        }
}
__device__ __forceinline__ void pack_p(const f32x16& s, bf16x8 (&pf)[2]) {
#pragma unroll
    for (int k = 0; k < 2; ++k) {
        u32x4 w; w.x = pg8::cvt_pk_bf16(s[8 * k + 0], s[8 * k + 1]); w.y = pg8::cvt_pk_bf16(s[8 * k + 2], s[8 * k + 3]); w.z = pg8::cvt_pk_bf16(s[8 * k + 4], s[8 * k + 5]); w.w = pg8::cvt_pk_bf16(s[8 * k + 6], s[8 * k + 7]);
        pf[k] = __builtin_bit_cast(bf16x8, w);
    }
}

__device__ __forceinline__ float swapmax(float v) {
    auto rr = __builtin_amdgcn_permlane32_swap(__float_as_uint(v), __float_as_uint(v), false, false);
    return fmaxf(__uint_as_float(rr[0]), __uint_as_float(rr[1]));
}
__device__ __forceinline__ float max16(const f32x16& s) {
    float a = __builtin_fmaxf(__builtin_fmaxf(s[0], s[1]), s[2]), b = __builtin_fmaxf(__builtin_fmaxf(s[3], s[4]), s[5]);
    a = __builtin_fmaxf(__builtin_fmaxf(a, s[6]), s[7]); b = __builtin_fmaxf(__builtin_fmaxf(b, s[8]), s[9]);
    a = __builtin_fmaxf(__builtin_fmaxf(a, s[10]), s[11]); b = __builtin_fmaxf(__builtin_fmaxf(b, s[12]), s[13]);
    a = __builtin_fmaxf(__builtin_fmaxf(a, s[14]), s[15]);
    return __builtin_fmaxf(a, b);
}
__device__ __forceinline__ void scale_rows(f32x16 (&o)[2], float f, float* wsf, int lane) {
    const int r32 = lane & 31, h = lane >> 5;
    if (h == 0) wsf[r32] = f;
    NSA_LWAIT();
#pragma unroll
    for (int i = 0; i < 16; ++i) { const float fi = wsf[crow(i, h)]; o[0][i] *= fi; o[1][i] *= fi; }
    NSA_LWAIT();
}
template <bool MASKED>
__device__ __forceinline__ void softmax_pv(f32x16 (&o)[2], float& m, float& lsum, f32x16& s, ldsp Vt, float* wsf, int lane) {
    float tmax = s[0];
#pragma unroll
    for (int i = 1; i < 16; ++i) tmax = fmaxf(tmax, s[i]);
    tmax = swapmax(tmax);
    if (__any(tmax > m + THR)) {
        const float mn = fmaxf(m, tmax), f = __builtin_amdgcn_exp2f(m - mn);
        lsum *= f; m = mn;
        scale_rows(o, f, wsf, lane);
    }
    float ps = 0.f;
#pragma unroll
    for (int i = 0; i < 16; ++i) { float pv = __builtin_amdgcn_exp2f(s[i] - m); if (MASKED) pv = s[i] > -1e29f ? pv : 0.f; s[i] = pv; ps += pv; }
    lsum += ps;
    bf16x8 pf[2]; pack_p(s, pf);
    pv32(o, Vt, pf, lane);
}

template <bool SEL>
__device__ __forceinline__ void softmax_pv2(f32x16 (&o)[2], float& m, float& lsum, f32x16& s0, f32x16& s1, ldsp Vt, float* wsf, int lane, bool lanesel) {
    float tmax = fmaxf(max16(s0), max16(s1));
    if (SEL) tmax = lanesel ? tmax : -1e30f;
    tmax = swapmax(tmax);
    if (__any(tmax > m + THR)) {
        const float mn = fmaxf(m, tmax), f = __builtin_amdgcn_exp2f(m - mn);
        lsum *= f; m = mn;
        scale_rows(o, f, wsf, lane);
    }
    const float mm = SEL ? (lanesel ? m : 1e30f) : m;
    float ps0 = 0.f, ps1 = 0.f;
#pragma unroll
    for (int i = 0; i < 16; ++i) { s0[i] = __builtin_amdgcn_exp2f(s0[i] - mm); ps0 += s0[i]; }
#pragma unroll
    for (int i = 0; i < 16; ++i) { s1[i] = __builtin_amdgcn_exp2f(s1[i] - mm); ps1 += s1[i]; }
    lsum += ps0 + ps1;
    bf16x8 pf0[2], pf1[2]; pack_p(s0, pf0); pack_p(s1, pf1);
    pv32(o, Vt, pf0, lane);
    pv32(o, Vt + 32 * KP * 2, pf1, lane);
}
__device__ __forceinline__ void load_q(bf16x8 (&qf)[4], const bf16_t* qp  ) {
#pragma unroll
    for (int ks = 0; ks < 4; ++ks) {
        const u32x4 w = *(const u32x4*)(qp + 16 * ks);
        const unsigned wv[4] = {w.x, w.y, w.z, w.w}; u32x4 o;
        unsigned ov[4];
#pragma unroll
        for (int j = 0; j < 4; ++j) ov[j] = pg8::cvt_pk_bf16(__uint_as_float(wv[j] << 16) * QSCALE, __uint_as_float(wv[j] & 0xffff0000u) * QSCALE);
        o.x = ov[0]; o.y = ov[1]; o.z = ov[2]; o.w = ov[3];
        qf[ks] = __builtin_bit_cast(bf16x8, o);
    }
}
__device__ __forceinline__ float gate_of(const bf16_t* zrow, int g, int hr, int br) { const float x = bf2f(zrow[ZC_NG + g * 12 + hr * 3 + br]); return 1.f / (1.f + __expf(-x)); }

__device__ __forceinline__ void softmax_rel(f32x16 (&o)[2], float& m, float& lsum, f32x16& s0, f32x16& s1, ldsp Vt, float* wsf, int lane) {
    const float tmax = swapmax(fmaxf(max16(s0), max16(s1)));
    if (__any(tmax > THR)) {
        const float d = fmaxf(tmax, 0.f), f = __builtin_amdgcn_exp2f(-d);
        m += d; lsum *= f;
        scale_rows(o, f, wsf, lane);
#pragma unroll
        for (int i = 0; i < 16; ++i) { s0[i] -= d; s1[i] -= d; }
    }
    float ps0 = 0.f, ps1 = 0.f;
#pragma unroll
    for (int i = 0; i < 16; ++i) { s0[i] = __builtin_amdgcn_exp2f(s0[i]); ps0 += s0[i]; }
#pragma unroll
    for (int i = 0; i < 16; ++i) { s1[i] = __builtin_amdgcn_exp2f(s1[i]); ps1 += s1[i]; }
    lsum += ps0 + ps1;
    bf16x8 pf0[2], pf1[2]; pack_p(s0, pf0); pack_p(s1, pf1);
    pv32(o, Vt, pf0, lane);
    pv32(o, Vt + 32 * KP * 2, pf1, lane);
}
__device__ __forceinline__ f32x16 splat16(float v) { return (f32x16){v, v, v, v, v, v, v, v, v, v, v, v, v, v, v, v}; }
__device__ __forceinline__ void softmax_rel1(f32x16 (&o)[2], float& m, float& lsum, f32x16& s0, ldsp Vt, float* wsf, int lane) {
    const float tmax = swapmax(max16(s0));
    if (__any(tmax > THR)) {
        const float d = fmaxf(tmax, 0.f), f = __builtin_amdgcn_exp2f(-d);
        m += d; lsum *= f;
        scale_rows(o, f, wsf, lane);
#pragma unroll
        for (int i = 0; i < 16; ++i) s0[i] -= d;
    }
    float ps0 = 0.f;
#pragma unroll
    for (int i = 0; i < 16; ++i) { s0[i] = __builtin_amdgcn_exp2f(s0[i]); ps0 += s0[i]; }
    lsum += ps0;
    bf16x8 pf0[2]; pack_p(s0, pf0);
    pv32(o, Vt, pf0, lane);
}
__device__ __forceinline__ void cmpwin_item(const bf16_t* Z, const bf16_t* KCb, const bf16_t* VCb, unsigned* SELMASK, bf16_t* Y, unsigned char* lds, int bg, int qt) {
    const int tid = tidx(), lane = tid & 63, wave = tid >> 6, r32 = lane & 31, h = lane >> 5;
    const int b_ = bg >> 1, g = bg & 1, tl = r32 >> 2, hr = r32 & 3;
    const int t = 64 * qt + 8 * wave + tl;
    const unsigned tok = (unsigned)(b_ * SEQ + t);
    const float* bt = (const float*)(lds + OFF_BT) + (g * 4 + hr) * BTP;
    float* wsf = (float*)(lds + OFF_WS + wave * WS_PER_WAVE);
    float* pmain = wsf + 64; float* pspill = pmain + 1024;
    const ldsp KL = (ldsp)lds + OFF_K + (r32 * KP + 8 * h) * 2;
    const ldsp VL = (ldsp)lds + OFF_V + ((4 * h + ((lane & 15) >> 2)) * KP + 16 * ((lane >> 4) & 1) + 4 * (lane & 3)) * 2;
    bf16x8 qf[4]; load_q(qf, Z + (tok * ZLD + ZC_NQ + g * 256 + hr * 64 + 8 * h));
    const f32x16 zero16 = (f32x16){0, 0, 0, 0, 0, 0, 0, 0, 0, 0, 0, 0, 0, 0, 0, 0};
    TileRegs tr;
    int buf = 0;
    const int cmax = min(4 * qt + 2, 510), nct = cmax / 64 + 1;
    const int cv = t >= 31 ? ((t - 31) >> 4) : -1;
    const bf16_t* kc = KCb + (unsigned)(bg * 512 * 64); const bf16_t* vc = VCb + (unsigned)(bg * 512 * 64);
    const bool dosel = qt >= 16;
    float m = -1e30f, l = 0.f;
    const float bfar = bt[1023];
    const int tmin = 64 * qt + 8 * wave;
    const int cvmin = tmin >= 31 ? ((tmin - 31) >> 4) : -1;
#define CMP_FAST(cbase) (((cbase) + 31 <= cvmin) && (tmin - 31 - 16 * ((cbase) + 31) >= 790))
    tile_load(tr, kc, vc, 64, 0);
    for (int j = 0; j < nct; ++j) {
        tile_store(lds, buf, tr); __syncthreads();
        if (j + 1 < nct) tile_load(tr, kc, vc, 64, 64 * (j + 1));
#pragma unroll
        for (int sub = 0; sub < 2; ++sub) {
            const int cbase = 64 * j + 32 * sub;
            if (cbase <= cmax) {
                const bool fast = CMP_FAST(cbase);
                f32x16 s = qk32(KL + buf * TILE_B + sub * 32 * KP * 2, qf, splat16(fast ? bfar : 0.f), r32, h);
                if (!fast) {
                    const int db = t - 31 - 16 * (cbase + 4 * h);
#pragma unroll
                    for (int i = 0; i < 16; ++i) {
                        const int co = (i & 3) + 8 * (i >> 2);
                        const float v = s[i] + bt[min((unsigned)(db - 16 * co), 1023u)];
                        s[i] = (cbase + 4 * h + co <= cv) ? v : -1e30f;
                    }
                }
                const float mn = fmaxf(m, swapmax(max16(s)));
                float ps = 0.f;
#pragma unroll
                for (int i = 0; i < 16; ++i) ps += __builtin_amdgcn_exp2f(s[i] - mn);
                l = (mn > -1e29f) ? l * __builtin_amdgcn_exp2f(m - mn) + ps : 0.f; m = mn;
            }
        }
        buf ^= 1;
    }
    l = swapadd(l);
    const float cb = (l > 0.f) ? -m - __builtin_amdgcn_logf(l) : 0.f;
    f32x16 oc[2] = {zero16, zero16};
    __syncthreads();
    tile_load(tr, kc, vc, 64, 0);
    for (int j = 0; j < nct; ++j) {
        tile_store(lds, buf, tr); __syncthreads();
        if (j + 1 < nct) tile_load(tr, kc, vc, 64, 64 * (j + 1));
#pragma unroll
        for (int sub = 0; sub < 2; ++sub) {
            const int cbase = 64 * j + 32 * sub;
            if (cbase <= cmax) {
                const bool fast = CMP_FAST(cbase);
                f32x16 s = qk32(KL + buf * TILE_B + sub * 32 * KP * 2, qf, splat16(fast ? bfar + cb : cb), r32, h);
                if (fast) {
#pragma unroll
                    for (int i = 0; i < 16; ++i) s[i] = __builtin_amdgcn_exp2f(s[i]);
                } else {
                    const int db = t - 31 - 16 * (cbase + 4 * h);
#pragma unroll
                    for (int i = 0; i < 16; ++i) {
                        const int co = (i & 3) + 8 * (i >> 2);
                        const float v = s[i] + bt[min((unsigned)(db - 16 * co), 1023u)];
                        s[i] = (cbase + 4 * h + co <= cv) ? __builtin_amdgcn_exp2f(v) : 0.f;
                    }
                }
                if (dosel) {
#pragma unroll
                    for (int q = 0; q < 4; ++q) {
                        float mainv = 2.f * (s[4 * q] + s[4 * q + 1] + s[4 * q + 2]) + s[4 * q + 3], spv = s[4 * q + 3];
                        mainv += dpp_xor1(mainv); mainv += dpp_xor2(mainv); spv += dpp_xor1(spv); spv += dpp_xor2(spv);
                        if (hr == 0) {
                            const int jb = (cbase >> 2) + 2 * q + h;
                            pmain[tl * 128 + jb] = mainv;
                            if (jb + 1 < 128) pspill[tl * 128 + jb + 1] = spv;
                        }
                    }
                }
                bf16x8 pf[2]; pack_p(s, pf);
                pv32(oc, VL + buf * TILE_B + sub * 32 * KP * 2, pf, lane);
            }
        }
        buf ^= 1;
    }
#undef CMP_FAST
    NSA_LWAIT();
    {
        const int stok = lane >> 3, si = lane & 7;
        unsigned mybits = 0u;
        if (dosel) {
            float vals[16];
#pragma unroll
            for (int k = 0; k < 16; ++k) { const int jb = si + 8 * k; vals[k] = (jb >= 1 && jb <= qt - 2) ? pmain[stok * 128 + jb] + pspill[stok * 128 + jb] : -1.f; }
            for (int it = 0; it < 13; ++it) {
                float bv = -2.f; int bk = 0;
#pragma unroll
                for (int k = 0; k < 16; ++k) if (vals[k] > bv) { bv = vals[k]; bk = k; }
                int bj = si + 8 * bk;
                { float ov = dpp_xor1(bv); int oj = dppi_xor1(bj); if (ov > bv || (ov == bv && oj < bj)) { bv = ov; bj = oj; }
                  ov = dpp_xor2(bv); oj = dppi_xor2(bj); if (ov > bv || (ov == bv && oj < bj)) { bv = ov; bj = oj; }
                  ov = dpp_hmir(bv); oj = dppi_hmir(bj); if (ov > bv || (ov == bv && oj < bj)) { bv = ov; bj = oj; } }
                const bool mine = (bj & 7) == si; const int wk = bj >> 3;
#pragma unroll
                for (int k = 0; k < 16; ++k) if (mine && k == wk) vals[k] = -3.f;
                if (mine) mybits |= 1u << wk;
            }
            if (si == 0) mybits |= 1u;
            if (((qt - 1) & 7) == si) mybits |= 1u << ((qt - 1) >> 3);
            if ((qt & 7) == si) mybits |= 1u << (qt >> 3);
        } else {
#pragma unroll
            for (int k = 0; k < 16; ++k) if (si + 8 * k <= qt) mybits |= 1u << k;
        }
        unsigned wd[4];
#pragma unroll
        for (int w = 0; w < 4; ++w) {
            unsigned x = 0u;
#pragma unroll
            for (int kk = 0; kk < 4; ++kk) if ((mybits >> (4 * w + kk)) & 1u) x |= 1u << (si + 8 * kk);
            x |= (unsigned)dppi_xor1((int)x); x |= (unsigned)dppi_xor2((int)x); x |= (unsigned)dppi_hmir((int)x);
            wd[w] = x;
        }
        if (si == 0) *(u32x4*)(SELMASK + (unsigned)((bg * SEQ + 64 * qt + 8 * wave + stok) * 4)) = (u32x4){wd[0], wd[1], wd[2], wd[3]};
    }
    { const int l2 = tidx() & 63, r2 = l2 & 31; const unsigned tk = (unsigned)(b_ * SEQ + 64 * qt + 8 * (tidx() >> 6) + (r2 >> 2)); scale_rows(oc, gate_of(Z + tk * ZLD, g, r2 & 3, 0), wsf, lane); }
    const unsigned yo = (unsigned)((b_ * SEQ + 64 * qt + 8 * wave + h) * DM + 512 + g * 256 + r32);
#pragma unroll
    for (int i = 0; i < 16; ++i) {
        const int ci = (i & 3) + 8 * (i >> 2);
        const unsigned o = yo + (unsigned)((ci >> 2) * DM + (ci & 3) * 64);
        Y[o] = f2bf(oc[0][i]); Y[o + 32] = f2bf(oc[1][i]);
    }
    f32x16 ow[2] = {zero16, zero16};
    m = 0.f; l = 0.f;
    const bf16_t* kw = Z + (unsigned)(b_ * SEQ * ZLD + ZC_NKV + 4 * 128 + g * 64); const bf16_t* vw = kw + 128;
    const int j0 = qt >= 8 ? qt - 8 : 0;
    __syncthreads();
    tile_load(tr, kw, vw, ZLD, 64 * j0);
    for (int j = j0; j <= qt; ++j) {
        tile_store(lds, buf, tr); __syncthreads();
        if (j < qt) tile_load(tr, kw, vw, ZLD, 64 * (j + 1));
        const bool edge = (j == qt) || (j == qt - 8);
        const f32x16 ci = splat16(-m);
        if (edge) {
#pragma unroll
            for (int sub = 0; sub < 2; ++sub) {
                const int kb = 64 * j + 32 * sub;
                if (kb > 64 * qt + 8 * wave + 7) continue;
                if (kb + 31 + 512 <= 64 * qt + 8 * wave) continue;
                f32x16 s = qk32(KL + buf * TILE_B + sub * 32 * KP * 2, qf, splat16(-m), r32, h);
                const int db = t - kb - 4 * h;
#pragma unroll
                for (int i = 0; i < 16; ++i) { const int dist = db - ((i & 3) + 8 * (i >> 2)); const float v = s[i] + bt[min((unsigned)dist, 1023u)]; s[i] = (dist >= 0 && dist < 512) ? v : -1e30f; }
                softmax_rel1(ow, m, l, s, VL + buf * TILE_B + sub * 32 * KP * 2, wsf, lane);
            }
        } else {
            f32x16 s0 = qk32(KL + buf * TILE_B, qf, ci, r32, h), s1 = qk32(KL + buf * TILE_B + 32 * KP * 2, qf, ci, r32, h);
            const int db = t - 64 * j - 4 * h;
#pragma unroll
            for (int i = 0; i < 16; ++i) { const int co = (i & 3) + 8 * (i >> 2); s0[i] += bt[db - co]; s1[i] += bt[db - 32 - co]; }
            softmax_rel(ow, m, l, s0, s1, VL + buf * TILE_B, wsf, lane);
        }
        buf ^= 1;
    }
    l = swapadd(l);
    { const int l2 = tidx() & 63, r2 = l2 & 31; const unsigned tk = (unsigned)(b_ * SEQ + 64 * qt + 8 * (tidx() >> 6) + (r2 >> 2)); scale_rows(ow, gate_of(Z + tk * ZLD, g, r2 & 3, 2) / fmaxf(l, 1e-30f), wsf, lane); }
#pragma unroll
    for (int i = 0; i < 16; ++i) {
        const int ci = (i & 3) + 8 * (i >> 2);
        const unsigned o = yo + (unsigned)((ci >> 2) * DM + (ci & 3) * 64);
        Y[o] = f2bf(bf2f(Y[o]) + ow[0][i]); Y[o + 32] = f2bf(bf2f(Y[o + 32]) + ow[1][i]);
    }
    __syncthreads();
}
constexpr int S2_TILE = 128 * KP * 2;
constexpr int S2_K = OFF_K, S2_V = S2_K + 2 * S2_TILE, S2_WS = S2_V + 2 * S2_TILE;
static_assert(S2_WS + 8 * 256 <= LDS_BYTES - 64, "slc lds");
struct TileRegs2 { u32x4 k0, k1, v0, v1; };
__device__ __forceinline__ void tile_load2(TileRegs2& r, const bf16_t* kb, const bf16_t* vb, int r0, int rmax) {
    const int ra = min(r0 + (tidx() >> 3), rmax), rb = min(r0 + 64 + (tidx() >> 3), rmax);
    const unsigned oa = (unsigned)ra * ZLD + (tidx() & 7) * 8, ob = (unsigned)rb * ZLD + (tidx() & 7) * 8;
    r.k0 = *(const u32x4*)(kb + oa); r.v0 = *(const u32x4*)(vb + oa); r.k1 = *(const u32x4*)(kb + ob); r.v1 = *(const u32x4*)(vb + ob);
}
__device__ __forceinline__ void tile_store2(unsigned char* lds, int buf, const TileRegs2& r) {
    const int o = ((tidx() >> 3) * KP + (tidx() & 7) * 8) * 2;
    *(u32x4*)(lds + S2_K + buf * S2_TILE + o) = r.k0; *(u32x4*)(lds + S2_K + buf * S2_TILE + 64 * KP * 2 + o) = r.k1;
    *(u32x4*)(lds + S2_V + buf * S2_TILE + o) = r.v0; *(u32x4*)(lds + S2_V + buf * S2_TILE + 64 * KP * 2 + o) = r.v1;
}
__device__ __forceinline__ void slc_item(const bf16_t* Z, const unsigned* SELMASK, bf16_t* Y, unsigned char* lds, int bg, int qt, float dsc) {
    const int tid = tidx(), lane = tid & 63, wave = tid >> 6, r32 = lane & 31, h = lane >> 5;
    const int b_ = bg >> 1, g = bg & 1, tl = r32 >> 2, hr = r32 & 3;
    const int t = 64 * qt + 8 * wave + tl;
    const unsigned tok = (unsigned)(b_ * SEQ + t);
    const float* bt = (const float*)(lds + OFF_BT) + (g * 4 + hr) * BTP;
    float* wsf = (float*)(lds + S2_WS + wave * 256);
    const ldsp KL = (ldsp)lds + S2_K + (r32 * KP + 8 * h) * 2;
    const ldsp VL = (ldsp)lds + S2_V + ((4 * h + ((lane & 15) >> 2)) * KP + 16 * ((lane >> 4) & 1) + 4 * (lane & 3)) * 2;
    bf16x8 qf[4]; load_q(qf, Z + (tok * ZLD + ZC_NQ + g * 256 + hr * 64 + 8 * h));
    const u32x4 mk = *(const u32x4*)(SELMASK + (unsigned)((bg * SEQ + t) * 4));
    const float bfar = bt[1023];
    f32x16 o[2] = {splat16(0.f), splat16(0.f)};
    float m = 0.f, l = 0.f;
    const bf16_t* ksl = Z + (unsigned)(b_ * SEQ * ZLD + ZC_NKV + 2 * 128 + g * 64); const bf16_t* vsl = ksl + 128;
    const int rmax = 64 * qt + 63, nstep = (qt >> 1) + 1;
    TileRegs2 tr; int buf = 0;
    tile_load2(tr, ksl, vsl, 0, rmax);
    for (int st = 0; st < nstep; ++st) {
        tile_store2(lds, buf, tr); __syncthreads();
        if (st + 1 < nstep) tile_load2(tr, ksl, vsl, 128 * (st + 1), rmax);
#pragma unroll
        for (int hb = 0; hb < 2; ++hb) {
            const int j = 2 * st + hb;
            if (j > qt) break;
            const int jw = j >> 5;
            const unsigned mw = jw == 0 ? mk.x : (jw == 1 ? mk.y : (jw == 2 ? mk.z : mk.w));
            const bool sel = (mw >> (j & 31)) & 1u;
            if (!__any(sel)) continue;
            const ldsp Kt = KL + buf * S2_TILE + hb * 64 * KP * 2;
            const ldsp Vt = VL + buf * S2_TILE + hb * 64 * KP * 2;
            const bool near = (qt - j) < 14;
            const f32x16 ci = splat16(sel ? (near ? 0.f : bfar) - m : -1e30f);
            f32x16 s0 = qk32(Kt, qf, ci, r32, h), s1 = qk32(Kt + 32 * KP * 2, qf, ci, r32, h);
            if (near) {
                const int db = t - 64 * j - 4 * h;
                if (j == qt) {
#pragma unroll
                    for (int i = 0; i < 16; ++i) { const int co = (i & 3) + 8 * (i >> 2); const int d0 = db - co, d1 = db - 32 - co;
                        s0[i] = d0 >= 0 ? s0[i] + bt[min((unsigned)d0, 1023u)] : -1e30f; s1[i] = d1 >= 0 ? s1[i] + bt[min((unsigned)d1, 1023u)] : -1e30f; }
                } else {
#pragma unroll
                    for (int i = 0; i < 16; ++i) { const int co = (i & 3) + 8 * (i >> 2); s0[i] += bt[min(db - co, 1023)]; s1[i] += bt[min(db - 32 - co, 1023)]; }
                }
            }
            softmax_rel(o, m, l, s0, s1, Vt, wsf, lane);
        }
        buf ^= 1;
    }
    l = swapadd(l);
    scale_rows(o, dsc * gate_of(Z + tok * ZLD, g, hr, 1) / fmaxf(l, 1e-30f), wsf, lane);
    const unsigned yo = (unsigned)((b_ * SEQ + 64 * qt + 8 * wave + h) * DM + 512 + g * 256 + r32);
#pragma unroll
    for (int i = 0; i < 16; ++i) {
        const int ci = (i & 3) + 8 * (i >> 2);
        const unsigned oo = yo + (unsigned)((ci >> 2) * DM + (ci & 3) * 64);
        Y[oo] = f2bf(bf2f(Y[oo]) + o[0][i]); Y[oo + 32] = f2bf(bf2f(Y[oo + 32]) + o[1][i]);
    }
    __syncthreads();
}
}


namespace cmpr {
typedef short bf16x8 __attribute__((ext_vector_type(8)));
constexpr int OFF_PART = 0, OFF_HID = 32768, CMPR_LDS = OFF_HID + 16 * 72 * 2;
__device__ __forceinline__ void item(const bf16_t* Z, const bf16_t* W1t, const bf16_t* W2t, const float* posb, bf16_t* OUT, unsigned char* lds, int bg, int kv, int nt) {
    const int tid = tidx(), lane = tid & 63, wave = tid >> 6, row = lane & 15, kq = lane >> 4;
    const int b_ = bg >> 1, g = bg & 1, n = 16 * nt + row;
    f32x4 acc[4];
#pragma unroll
    for (int mt = 0; mt < 4; ++mt) acc[mt] = (f32x4){0.f, 0.f, 0.f, 0.f};
    const unsigned zbase = (unsigned)(b_ * SEQ * ZLD + ZC_NKV + kv * 128 + g * 64 + 8 * kq);
#pragma unroll
    for (int kk = 0; kk < 8; ++kk) {
        const int ks = 8 * wave + kk;
        const int tok = min(16 * n + (ks >> 1), SEQ - 1);
        const bf16x8 a = *(const bf16x8*)(Z + (zbase + (unsigned)(tok * ZLD + 32 * (ks & 1))));
#pragma unroll
        for (int mt = 0; mt < 4; ++mt) {
            const bf16x8 bq = *(const bf16x8*)(W1t + (unsigned)((16 * mt + row) * 2048 + 32 * ks + 8 * kq));
            acc[mt] = __builtin_amdgcn_mfma_f32_16x16x32_bf16(a, bq, acc[mt], 0, 0, 0);
        }
    }
    float* part = (float*)(lds + OFF_PART) + wave * 1024;
#pragma unroll
    for (int mt = 0; mt < 4; ++mt)
#pragma unroll
        for (int r = 0; r < 4; ++r) part[(4 * kq + r) * 64 + 16 * mt + row] = acc[mt][r];
    __syncthreads();
    bf16_t* hid = (bf16_t*)(lds + OFF_HID);
    {
        const int nn = tid >> 5, m2 = (tid & 31) * 2;
        float s0 = 0.f, s1 = 0.f;
#pragma unroll
        for (int w = 0; w < 8; ++w) { const float2 v = *(const float2*)((const float*)(lds + OFF_PART) + w * 1024 + nn * 64 + m2); s0 += v.x; s1 += v.y; }
        *(unsigned*)(hid + nn * 72 + m2) = pg8::cvt_pk_bf16(gelu_tanh(s0 + posb[m2]), gelu_tanh(s1 + posb[m2 + 1]));
    }
    __syncthreads();
    if (wave < 4) {
        const int et = wave;
        f32x4 o = (f32x4){0.f, 0.f, 0.f, 0.f};
#pragma unroll
        for (int ks = 0; ks < 2; ++ks) {
            const bf16x8 a = *(const bf16x8*)(lds + OFF_HID + (row * 72 + 32 * ks + 8 * kq) * 2);
            const bf16x8 bq = *(const bf16x8*)(W2t + (16 * et + row) * 64 + 32 * ks + 8 * kq);
            o = __builtin_amdgcn_mfma_f32_16x16x32_bf16(a, bq, o, 0, 0, 0);
        }
#pragma unroll
        for (int r = 0; r < 4; ++r) { const int nn = 16 * nt + 4 * kq + r; OUT[(unsigned)((bg * 512 + nn) * 64 + 16 * et + row)] = (nn < NCMP) ? f2bf(o[r]) : (bf16_t)0; }
    }
    __syncthreads();
}
}
#define LAS __attribute__((address_space(3)))
#define XB_TMO      128
#define XB_XCNT(j)  (256  + 64 * (j))
#define XB_XSUB(j)  (1280 + 64 * (j))
#define XB_XGEN(j)  (2304 + 64 * (j))
#define XB_TOP      3328
#define XB_TOPGEN   3392
#define XCD_BAR_WORDS 3456
#define XB_SPIN_CAP (1u << 18)

__device__ __forceinline__ unsigned xb_ld(unsigned* p)              { return __hip_atomic_load(p, __ATOMIC_RELAXED, __HIP_MEMORY_SCOPE_AGENT); }
__device__ __forceinline__ unsigned xb_add(unsigned* p, unsigned v) { return __hip_atomic_fetch_add(p, v, __ATOMIC_RELAXED, __HIP_MEMORY_SCOPE_AGENT); }
__device__ __forceinline__ unsigned xb_xcc_id() { return (unsigned)__builtin_amdgcn_s_getreg((3 << 11) | 20) & 0xFu; }
#define XB_SPIN(cond, bar) do { unsigned _sp = 0; while (cond) { __builtin_amdgcn_s_sleep(1); \
    if ((++_sp & 255u) == 0u) { if (xb_ld(&(bar)[XB_TMO])) break; if (_sp > XB_SPIN_CAP) { atomicAdd(&(bar)[XB_TMO], 1u); break; } } } } while (0)

struct XcdBarrier {
    unsigned* bar; unsigned x;
    volatile LAS unsigned* st;
};

__device__ __forceinline__ XcdBarrier xcd_barrier_post(unsigned* bar, volatile LAS unsigned* st) {
    XcdBarrier b; b.bar = bar; b.x = xb_xcc_id(); b.st = st;
    if (threadIdx.x == 0) (void)xb_add(&bar[XB_XCNT(b.x)], 1u);
    return b;
}
__device__ __forceinline__ void xcd_barrier_complete(unsigned* bar, unsigned x, unsigned& nloc, unsigned& nx) {
    const unsigned G = gridDim.x * gridDim.y * gridDim.z;
    unsigned sum, cnt, mine, sp = 0u;
    for (;;) {
        sum = 0u; cnt = 0u; mine = 0u;
#pragma unroll
        for (unsigned j = 0; j < 16; ++j) { const unsigned c = xb_ld(&bar[XB_XCNT(j)]); sum += c; cnt += (c > 0u) ? 1u : 0u; mine = (j == x) ? c : mine; }
        if (sum == G) break;
        __builtin_amdgcn_s_sleep(1);
        if ((++sp & 255u) == 0u) { if (xb_ld(&bar[XB_TMO])) break; if (sp > XB_SPIN_CAP) { atomicAdd(&bar[XB_TMO], 1u); break; } }
    }
    nloc = mine > 0u ? mine : 1u; nx = cnt > 0u ? cnt : 1u;
}

__device__ __forceinline__ void xcd_barrier(const XcdBarrier& b) {
    asm volatile("s_waitcnt vmcnt(0)" ::: "memory");
    __syncthreads();
    if (threadIdx.x == 0) {
        unsigned* bar = b.bar;
        __builtin_amdgcn_s_waitcnt(0);
        unsigned nloc = b.st[0], nx = b.st[1];
        if (nloc == 0u) { xcd_barrier_complete(bar, b.x, nloc, nx); b.st[0] = nloc; b.st[1] = nx; }
        const unsigned old = xb_add(&bar[XB_XSUB(b.x)], 1u);
        const unsigned gen = old / nloc;
        if (old + 1u == (gen + 1u) * nloc) {
            __builtin_amdgcn_fence(__ATOMIC_RELEASE, "agent");
            asm volatile("s_waitcnt vmcnt(0)" ::: "memory");
            const unsigned og = xb_add(&bar[XB_TOP], 1u);
            const unsigned tg = og / nx;
            if (og + 1u == (tg + 1u) * nx) xb_add(&bar[XB_TOPGEN], 1u);
            else XB_SPIN(xb_ld(&bar[XB_TOPGEN]) == tg, bar);
            __builtin_amdgcn_fence(__ATOMIC_ACQUIRE, "agent");
            xb_add(&bar[XB_XGEN(b.x)], 1u);
            asm volatile("s_waitcnt vmcnt(0)" ::: "memory");
        } else {
            XB_SPIN(xb_ld(&bar[XB_XGEN(b.x)]) == gen, bar);
            __builtin_amdgcn_fence(__ATOMIC_ACQUIRE, "agent");
            asm volatile("s_waitcnt vmcnt(0)" ::: "memory");
        }
    }
    __syncthreads();
}

template <int L, int WHICH>
__device__ __forceinline__ void convert_group(const Params& p, float* lds, int wrank, int nwaves) {
    unsigned char* wl = p.ws + WS_W + L * W_LAYER;
    int cwg = wrank; const int NGW = nwaves;
    if constexpr (WHICH == 0) {
        convert_wt(p.in[2] + (size_t)L * DM * DFF, DM, DFF, p.in[1] + L * DM, (bf16_t*)(wl + W_GU1), 0, 0, lds, cwg, NGW);
        convert_wt(p.in[3] + (size_t)L * DM * DFF, DM, DFF, p.in[1] + L * DM, (bf16_t*)(wl + W_GU1), 0, 128, lds, cwg, NGW);
        convert_wt(p.in[4] + (size_t)L * DM * DFF, DFF, DM, nullptr, (bf16_t*)(wl + W_D1), 1, 0, lds, cwg, NGW);
    } else {
        convert_wt(p.in[6] + (size_t)L * DM * DIN, DM, DIN, p.in[5] + L * DM, (bf16_t*)(wl + W_IN), 1, 0, lds, cwg, NGW);
        convert_wt(p.in[7] + (size_t)L * DM * DM, DM, DM, nullptr, (bf16_t*)(wl + W_OUT), 1, 0, lds, cwg, NGW);
        convert_wt(p.in[27] + (size_t)L * DM * DFF, DM, DFF, p.in[26] + L * DM, (bf16_t*)(wl + W_GU2), 0, 0, lds, cwg, NGW);
        convert_wt(p.in[28] + (size_t)L * DM * DFF, DM, DFF, p.in[26] + L * DM, (bf16_t*)(wl + W_GU2), 0, 128, lds, cwg, NGW);
        convert_wt(p.in[29] + (size_t)L * DM * DFF, DFF, DM, nullptr, (bf16_t*)(wl + W_D2), 1, 0, lds, cwg, NGW);
        bf16_t* win = (bf16_t*)(wl + W_IN);
        for (int i = wrank * 64 + (tidx() & 63); i < (ZLD - DIN) * DM; i += nwaves * 64) win[DIN * DM + i] = 0;
    }
}

constexpr int ST_PER_LAYER = 10, NSTAGES = 1 + 2 * ST_PER_LAYER + 1;

template <class Epi, bool LDAK = true>
__device__ __forceinline__ void gemm_stage(float* lds, const bf16_t* A, const bf16_t* Bt, int N, int K, const Epi& E, int lda = 0) {
    pg8::Gemm g{A, Bt, MTOK, N, K, lda ? lda : K};
    pg8::StaticOrder S; S.init(MTOK, N, (int)gridDim.x, (int)blockIdx.x);
    pg8::gemm_phase<Epi, pg8::StaticOrder, true, true, LDAK>((PG8_LAS unsigned char*)lds, g, S, E);
}

template <int st>
__device__ __forceinline__ void run_stage(const Params& p, float* lds, float dsc = 1.0f) {
    const int bid = blockIdx.x, nb = gridDim.x, tid = tidx(), wave = tid >> 6;
    unsigned char* ws = p.ws;
    float* SSQ = (float*)(ws + WS_SMALL + SM_SSQ);
    float* LB = (float*)(ws + WS_SMALL + SM_LB);
    bf16_t* KC = (bf16_t*)(ws + WS_SMALL + SM_KC);
    bf16_t* VC = (bf16_t*)(ws + WS_SMALL + SM_VC);
    bf16_t* XB = (bf16_t*)(ws + WS_XB);
    unsigned char* msc = (unsigned char*)p.X;
    bf16_t* HZ = (bf16_t*)(ws + WS_HZ);
    bf16_t* Y = (bf16_t*)(ws + WS_Y);
    if constexpr (st == 0) {
        const int NGW = nb * NWAVE; int cwg = bid * NWAVE + wave;
        convert_group<0, 0>(p, lds, cwg, NGW);
        cwg = bid * NWAVE + wave;
        for (int l = 0; l < 2; ++l) {
            s5_tables(p, l, (float*)(ws + WS_SMALL + SM_S5AB + l * SM_S5_LAYER), bid * NT + tid, nb * NT);
            convert_wt(p.in[16] + (size_t)l * 65536, 256, 256, nullptr, (bf16_t*)(ws + WS_SMALL + SM_WGLU) + l * 65536, 1, 0, lds, cwg, NGW);
            for (int kv = 0; kv < 2; ++kv) {
                convert_wt(p.in[kv ? 23 : 20] + (size_t)l * 131072, 2048, 64, nullptr, (bf16_t*)(ws + WS_SMALL + SM_W1T) + (l * 2 + kv) * 131072, 1, 0, lds, cwg, NGW);
                convert_wt(p.in[kv ? 24 : 21] + (size_t)l * 4096, 64, 64, nullptr, (bf16_t*)(ws + WS_SMALL + SM_W2T) + (l * 2 + kv) * 4096, 1, 0, lds, cwg, NGW);
            }
            for (int i = bid * NWAVE + wave; i < 128; i += nb * NWAVE) {
                const int kv = i >> 6, m = i & 63, ln = tid & 63; const float* pos = p.in[kv ? 22 : 19] + l * 2048; const float* w1 = p.in[kv ? 23 : 20] + (size_t)l * 131072;
                float a = 0.f;
#pragma unroll 8
                for (int q = ln; q < 2048; q += 64) a += pos[q] * w1[(size_t)q * 64 + m];
                a = wave_sum(a);
                if (ln == 0) ((float*)(ws + WS_SMALL + SM_POSB))[(l * 2 + kv) * 64 + m] = a;
            }
        }
        s5::pow_table(p, (float*)(ws + WS_POW), bid * NT + tid, nb * NT);
        for (int i = bid * NT + tid; i < 256; i += nb * NT) {
            const float a = p.in[17][i], bq = p.in[17][256 + i], mx = fmaxf(a, bq);
            const float ea = expf(a - mx), eb = expf(bq - mx);
            LB[i] = 0.f; LB[256 + i] = eb / (ea + eb);
        }
        rowstats(p.in[0], const_cast<float*>(p.in[0]), XB, SSQ, bid, nb);
        __syncthreads();
        return;
    }
    if constexpr (st == NSTAGES - 1) { final_norm(p.X, SSQ, p.in[30], bid, nb); return; }
    constexpr int l = (st - 1) / ST_PER_LAYER, s = (st - 1) % ST_PER_LAYER;
    unsigned char* wl = ws + WS_W + l * W_LAYER;
    if constexpr (s == 0) {
        if constexpr (l == 0) {
            for (int ll = 0; ll < 2; ++ll) {
                s5::build_tables(p, ll, (const float*)(ws + WS_POW), (const float*)(ws + WS_SMALL + SM_S5AB + ll * SM_S5_LAYER), ws + WS_S5T + (size_t)ll * s5::T_LAYER, bid * NT + tid, nb * NT);
                for (int i = bid * NT + tid; i < 1024; i += nb * NT) { const float* pw = (const float*)(ws + WS_POW) + ((size_t)((ll * 16 + (i >> 6)) * 65 + 64) * 64 + (i & 63)) * 2; float* a64 = (float*)(ws + WS_SMALL + SM_A64) + (ll * 1024 + i) * 2; a64[0] = pw[0]; a64[1] = pw[1]; }
            }
        }
        gemm_stage(lds, XB, (const bf16_t*)(wl + W_GU1), 2 * DFF, DM, pg8::EpiGU{SSQ, HZ, DFF});
        if constexpr (l == 0) { if (nb == 256 && bid >= 128) convert_group<0, 1>(p, lds, (bid - 128) * NWAVE + wave, 128 * NWAVE); else if (nb != 256) convert_group<0, 1>(p, lds, bid * NWAVE + wave, nb * NWAVE); }
    }
    if constexpr (s == 1) gemm_stage(lds, HZ, (const bf16_t*)(wl + W_D1), DM, DFF, pg8::EpiResB<(l == 0), false>{p.in[0], p.X, XB, SSQ, 0.5f * dsc});
    if constexpr (s == 2) {
        gemm_stage(lds, XB, (const bf16_t*)(wl + W_IN), ZLD, DM, pg8::EpiZ{SSQ, HZ, ZLD});
        if constexpr (l == 0) { if (nb == 256 && bid >= 192) convert_group<1, 0>(p, lds, (bid - 192) * NWAVE + wave, 64 * NWAVE); else if (nb != 256) convert_group<1, 0>(p, lds, bid * NWAVE + wave, nb * NWAVE); }
    }
    if constexpr (s == 3) {
        for (int item = bid; item < 256; item += nb) s5::phase1(HZ, ws + WS_S5T + (size_t)l * s5::T_LAYER, (float*)(msc + WS_S5_XE), (unsigned char*)lds, item);
        for (int item = bid; item < 1024; item += nb) hg::phase1(HZ, LB + l * 256, (float*)(msc + WS_HG_DS), (float*)(msc + WS_HG_GAM), (unsigned char*)lds, item);
        for (int item = bid; item < 256; item += nb) {
            const int nt = item & 31, kv = (item >> 5) & 1, bg = item >> 6;
            cmpr::item(HZ, (const bf16_t*)(ws + WS_SMALL + SM_W1T) + (l * 2 + kv) * 131072, (const bf16_t*)(ws + WS_SMALL + SM_W2T) + (l * 2 + kv) * 4096,
                       (const float*)(ws + WS_SMALL + SM_POSB) + (l * 2 + kv) * 64, kv ? VC : KC, (unsigned char*)lds, bg, kv, nt);
        }
        __syncthreads();
    }
    if constexpr (s == 4) {
        if (bid < 64) hg::phase2((const float*)(msc + WS_HG_DS), (const float*)(msc + WS_HG_GAM), (bf16_t*)(msc + WS_HG_ST), bid * NT + tid);
        if (bid >= 64 && bid < 68) s5::phase2((const float*)(msc + WS_S5_XE), (const float*)(ws + WS_SMALL + SM_A64) + l * 2048, (bf16_t*)(msc + WS_S5_XC), (bid - 64) * NT + tid);
        nsa::fill_btab(p.in[25], (unsigned char*)lds);
        __syncthreads();
        for (int w = bid; w < 256; w += nb) {
            const int bg = w >> 6, i = w & 63;
            for (int rep = 0; rep < 2; ++rep) nsa::cmpwin_item(HZ, KC, VC, (unsigned*)(msc + WS_SELMASK), Y, (unsigned char*)lds, bg, rep ? 127 - i : i);
        }
    }
    if constexpr (s == 5) {
        for (int item = bid; item < 256; item += nb) s5::phase3(p, l, HZ, ws + WS_S5T + (size_t)l * s5::T_LAYER, (const bf16_t*)(msc + WS_S5_XC), Y, (unsigned char*)lds, item);
        for (int item = bid; item < 1024; item += nb) hg::phase3(HZ, LB + l * 256, p.in[18] + l * 64, (const bf16_t*)(msc + WS_HG_ST), Y, (unsigned char*)lds, item);
        nsa::fill_btab(p.in[25], (unsigned char*)lds);
        __syncthreads();
        for (int w = bid; w < 256; w += nb) {
            const int bg = w >> 6, i = w & 63;
            for (int rep = 0; rep < 2; ++rep) nsa::slc_item(HZ, (const unsigned*)(msc + WS_SELMASK), Y, (unsigned char*)lds, bg, rep ? 127 - i : i, dsc);
        }
    }
    if constexpr (s == 6) gemm_stage<pg8::EpiGLU, false>(lds, Y, (const bf16_t*)(ws + WS_SMALL + SM_WGLU) + l * 65536, 256, 256, pg8::EpiGLU{Y}, DM);
    if constexpr (s == 7) gemm_stage(lds, Y, (const bf16_t*)(wl + W_OUT), DM, DM, pg8::EpiResB<false, false>{nullptr, p.X, XB, SSQ, 1.0f * dsc});
    if constexpr (s == 8) {
        gemm_stage(lds, XB, (const bf16_t*)(wl + W_GU2), 2 * DFF, DM, pg8::EpiGU{SSQ, HZ, DFF});
        if constexpr (l == 0) { if (nb == 256 && bid >= 128) convert_group<1, 1>(p, lds, (bid - 128) * NWAVE + wave, 128 * NWAVE); else if (nb != 256) convert_group<1, 1>(p, lds, bid * NWAVE + wave, nb * NWAVE); }
    }
    if constexpr (s == 9) gemm_stage(lds, HZ, (const bf16_t*)(wl + W_D2), DM, DFF, pg8::EpiResB<false, (l == 1)>{nullptr, p.X, XB, SSQ, 0.5f * dsc});
}

template <int ST>
__device__ __forceinline__ void run_all(const Params& p, float* lds, cg::grid_group& grid, const XcdBarrier& bar) {
#ifdef DUP_ST
    if (ST == DUP_ST) { run_stage<ST>(p, lds, 0.0f); xcd_barrier(bar); }
#endif
    if (p.st_lo <= ST && ST < p.st_hi) {
        run_stage<ST>(p, lds);
        if (ST + 1 < p.st_hi) { if (p.st_hi < 0) grid.sync(); else xcd_barrier(bar); }
    }
    if constexpr (ST + 1 < NSTAGES) run_all<ST + 1>(p, lds, grid, bar);
}

__global__ void __launch_bounds__(NT, 2) fwd_kernel(Params p) {
    extern __shared__ __attribute__((aligned(16))) unsigned char lds_raw[];
    cg::grid_group grid = cg::this_grid();
    float* lds = (float*)lds_raw;
    volatile LAS unsigned* bst = (volatile LAS unsigned*)((LAS unsigned char*)lds_raw + LDS_BYTES - 64);
    if (tidx() < 16) bst[tidx()] = 0u;
    __syncthreads();
    const XcdBarrier bar = xcd_barrier_post((unsigned*)(p.ws + WS_CTL) + 1024, bst);
    run_all<0>(p, lds, grid, bar);
}

extern "C" void kernel_launch(void* const* d_in, const int* in_sizes, int n_in,
                              void* d_out, int out_size, void* d_ws, size_t ws_size,
                              hipStream_t stream) {
    static int grid_blocks = 0;
    if (!grid_blocks) {
        int dev = 0, cus = 0, per_cu = 0;
        (void)hipGetDevice(&dev);
        (void)hipDeviceGetAttribute(&cus, hipDeviceAttributeMultiprocessorCount, dev);
        (void)hipFuncSetAttribute((const void*)fwd_kernel, hipFuncAttributeMaxDynamicSharedMemorySize, LDS_BYTES);
        (void)hipOccupancyMaxActiveBlocksPerMultiprocessor(&per_cu, (const void*)fwd_kernel, NT, LDS_BYTES);
        if (per_cu < 1) { fprintf(stderr, "occupancy query says %d blocks/CU\n", per_cu); per_cu = 1; }
        grid_blocks = cus;
        if (ws_size < WS_END) fprintf(stderr, "workspace too small: %zu < %zu\n", ws_size, (size_t)WS_END);
    }
    Params p{};
    for (int i = 0; i < 31; ++i) p.in[i] = (const float*)d_in[i];
    p.X = (float*)d_out; p.ws = (unsigned char*)d_ws; p.st_lo = 0; p.st_hi = NSTAGES;
    (void)hipMemsetAsync((char*)d_ws + WS_CTL, 0, 65536, stream);
    void* args[] = {&p};
    hipError_t e = hipLaunchCooperativeKernel((void*)fwd_kernel, dim3(grid_blocks), dim3(NT), args, LDS_BYTES, stream);
    if (e != hipSuccess) fprintf(stderr, "cooperative launch failed: %s (grid %d)\n", hipGetErrorString(e), grid_blocks);
}
```

```cpp
#include <hip/hip_runtime.h>
#include <hip/hip_cooperative_groups.h>
#include <cstdio>
#include <cstdint>
namespace cg = cooperative_groups;

typedef unsigned short bf16_t;
typedef float f32x4 __attribute__((ext_vector_type(4)));
__device__ __forceinline__ int tidx() { int t = __builtin_amdgcn_workitem_id_x(); asm volatile("" : "+v"(t)); return t; }

constexpr int BSZ = 2, SEQ = 8192, DM = 1024, MTOK = BSZ * SEQ, DFF = 2816, DIN = 2584, ZLD = 2816;
constexpr int NT = 512, NWAVE = 8;
constexpr int LDS_BYTES = 147456;
constexpr float EPS = 1e-6f;
constexpr int ZC_U = 0, ZC_HQ = 256, ZC_HF = 512, ZC_HI = 768, ZC_HG = 1024, ZC_NQ = 1280, ZC_NKV = 1792, ZC_NG = 2560;
constexpr int NCMP = 511;

constexpr size_t MiB = 1u << 20;
constexpr size_t WS_CTL = 0;
constexpr size_t WS_W = 1 * MiB;
constexpr size_t W_GU1 = 0, W_D1 = 11 * MiB, W_IN = W_D1 + 5632 * 1024, W_OUT = W_IN + 5632 * 1024, W_GU2 = W_OUT + 2 * MiB, W_D2 = W_GU2 + 11 * MiB, W_LAYER = W_D2 + 5632 * 1024;
constexpr size_t WS_SMALL = WS_W + 2 * W_LAYER;
constexpr size_t SM_SSQ = 0;
constexpr size_t SM_S5AB = 1048576;
constexpr size_t SM_S5_LAYER = 139264;
constexpr size_t SM_LB = SM_S5AB + 2 * SM_S5_LAYER;
constexpr size_t SM_KC = SM_LB + 2048;
constexpr size_t SM_VC = SM_KC + 524288;
constexpr size_t SM_A64 = SM_VC + 524288;
constexpr size_t SM_WGLU = SM_A64 + 16384;
constexpr size_t SM_W1T = SM_WGLU + 262144;
constexpr size_t SM_W2T = SM_W1T + 1048576;
constexpr size_t SM_POSB = SM_W2T + 32768;
constexpr size_t SM_END = SM_POSB + 1024;
static_assert(SM_END <= 4 * MiB, "small region");
constexpr size_t WS_XB = WS_SMALL + 4 * MiB;
constexpr size_t WS_HG_DS = 0, WS_HG_ST = 16 * MiB, WS_HG_GAM = 24 * MiB;
constexpr size_t WS_HZ = WS_XB + 32 * MiB;
constexpr size_t WS_Y = WS_HZ + 88 * MiB;
constexpr size_t WS_S5T = WS_Y + 32 * MiB;
constexpr size_t WS_END = WS_S5T + 2 * 8921088;
constexpr size_t WS_POW = WS_Y;
constexpr size_t WS_S5_XE = 25 * MiB, WS_S5_XC = 27 * MiB, WS_SELMASK = 28 * MiB;
static_assert(WS_END <= 256 * MiB, "workspace");

struct Params {
    const float* in[31];
    float* X;
    unsigned char* ws;
    int st_lo, st_hi;
};

namespace pg8 {
#define PG8_LAS __attribute__((address_space(3)))
typedef unsigned short bf16_t;
typedef short bf16x8 __attribute__((ext_vector_type(8)));
typedef float f32x4 __attribute__((ext_vector_type(4)));
typedef unsigned u32x4 __attribute__((ext_vector_type(4)));
constexpr int BM = 256, BK = 64, HALF = 128, HTB = HALF * BK * 2  , STAGE_BYTES = 8 * HTB, NXCD = 8, WGM = 8;

__host__ __device__ __forceinline__ int lds_byte(int r, int c) { const int st = (r >> 4) * 2 + (c >> 5), rr = r & 15, cc = c & 31, ob = rr * 64 + cc * 2; return st * 1024 + (ob ^ (((ob >> 9) & 1) << 5)); }
__host__ __device__ __forceinline__ void stage_rc(int b, int& R, int& C) { const int st = b / 1024, sb = b % 1024, swz = sb ^ (((sb >> 9) & 1) << 5); R = (st >> 1) * 16 + swz / 64; C = (st & 1) * 32 + (swz % 64) / 2; }
__host__ __device__ __forceinline__ int perm32(int rho) { const int n = rho >> 4, i = rho & 15; return 8 * (i >> 2) + 4 * n + (i & 3); }

struct Unit { int pm, pn; };
struct Gemm { const bf16_t* A; const bf16_t* Bt; int M, N, K, lda; };

struct StaticOrder {
    int nM, nN, nwg, G, c;
    __host__ __device__ void init(int M, int N, int G_, int c_) { nM = M / BM; nN = N / BM; nwg = nM * nN; G = G_; c = c_; }
    __host__ __device__ bool next(int i, Unit& u) const {
        const long L = (long)i * G + c; if (L >= nwg) return false;
        int wgid = (int)L; { const int q = nwg / NXCD, r = nwg % NXCD, xcd = wgid % NXCD, off = wgid / NXCD; wgid = (xcd < r ? xcd * (q + 1) : r * (q + 1) + (xcd - r) * q) + off; }
        const int nig = WGM * nN, gid = wgid / nig, fm = gid * WGM, gsz = (nM - fm) < WGM ? (nM - fm) : WGM;
        u.pm = fm + ((wgid % nig) % gsz); u.pn = (wgid % nig) / gsz; return true;
    }
    __device__ __forceinline__ void a_ready(const Unit&) const {}
    __device__ __forceinline__ void done(const Unit&) const {}
};

__device__ __forceinline__ unsigned cvt_pk_bf16(float lo, float hi) { unsigned r; asm volatile("v_cvt_pk_bf16_f32 %0, %1, %2" : "=v"(r) : "v"(lo), "v"(hi)); return r; }

__device__ __forceinline__ float rstd16(const float* ssq16, int row) {
    const f32x4* s = (const f32x4*)(ssq16 + 16 * (size_t)row);
    const f32x4 a = s[0], b = s[1], c = s[2], d = s[3];
    const float t = ((a[0] + a[1]) + (a[2] + a[3])) + ((b[0] + b[1]) + (b[2] + b[3])) + ((c[0] + c[1]) + (c[2] + c[3])) + ((d[0] + d[1]) + (d[2] + d[3]));
    return __builtin_amdgcn_rsqf(t * (1.0f / 1024.0f) + 1e-6f);
}
__device__ __forceinline__ float silu_f(float x) { return x * __builtin_amdgcn_rcpf(1.0f + __builtin_amdgcn_exp2f(-1.4426950408889634f * x)); }
typedef unsigned u32x2 __attribute__((ext_vector_type(2)));
struct EpiGU {
    static constexpr bool PERM = true, AFTER_DRAIN = false;
    const float* ssq16; bf16_t* H; int ldh;
    __device__ __forceinline__ void operator()(const f32x4 (&acc)[2][2][4][2], const Unit& u, int wr, int wc, int fr, int fq) const {
#pragma unroll
        for (int ai = 0; ai < 2; ++ai)
#pragma unroll
            for (int m = 0; m < 4; ++m) {
                const int row = u.pm * BM + ai * HALF + wr * 64 + m * 16 + fr;
                const float rs = rstd16(ssq16, row);
                const f32x4 g0 = acc[ai][0][m][0] * rs, g1 = acc[ai][0][m][1] * rs, u0 = acc[ai][1][m][0] * rs, u1 = acc[ai][1][m][1] * rs;
                u32x4 w;
                w.x = cvt_pk_bf16(silu_f(g0[0]) * u0[0], silu_f(g0[1]) * u0[1]); w.y = cvt_pk_bf16(silu_f(g0[2]) * u0[2], silu_f(g0[3]) * u0[3]);
                w.z = cvt_pk_bf16(silu_f(g1[0]) * u1[0], silu_f(g1[1]) * u1[1]); w.w = cvt_pk_bf16(silu_f(g1[2]) * u1[2], silu_f(g1[3]) * u1[3]);
                *(u32x4*)(H + (size_t)row * ldh + u.pn * HALF + wc * 32 + 8 * fq) = w;
            }
    }
};
template <bool WXB = true>
struct EpiResT {
    static constexpr bool PERM = true, AFTER_DRAIN = false;
    const float* Xin; float* X; bf16_t* XB; float* ssq16; float scale;
    __device__ __forceinline__ void operator()(const f32x4 (&acc)[2][2][4][2], const Unit& u, int wr, int wc, int fr, int fq) const {
#pragma unroll
        for (int ai = 0; ai < 2; ++ai)
#pragma unroll
            for (int m = 0; m < 4; ++m) {
                const int row = u.pm * BM + ai * HALF + wr * 64 + m * 16 + fr;
                float ss = 0.f;
#pragma unroll
                for (int bj = 0; bj < 2; ++bj) {
                    const int col0 = u.pn * BM + bj * HALF + wc * 32 + 8 * fq;
                    float* px = X + (size_t)row * 1024 + col0; const float* pi = Xin + (size_t)row * 1024 + col0;
                    f32x4 x0 = *(const f32x4*)pi, x1 = *(const f32x4*)(pi + 4);
                    x0 = x0 + acc[ai][bj][m][0] * scale; x1 = x1 + acc[ai][bj][m][1] * scale;
                    *(f32x4*)px = x0; *(f32x4*)(px + 4) = x1;
                    ss += ((x0[0] * x0[0] + x0[1] * x0[1]) + (x0[2] * x0[2] + x0[3] * x0[3])) + ((x1[0] * x1[0] + x1[1] * x1[1]) + (x1[2] * x1[2] + x1[3] * x1[3]));
                    if (WXB) {
                        u32x4 w; w.x = cvt_pk_bf16(x0[0], x0[1]); w.y = cvt_pk_bf16(x0[2], x0[3]); w.z = cvt_pk_bf16(x1[0], x1[1]); w.w = cvt_pk_bf16(x1[2], x1[3]);
                        *(u32x4*)(XB + (size_t)row * 1024 + col0) = w;
                    }
                }
                ss += __shfl_xor(ss, 16); ss += __shfl_xor(ss, 32);
                if (fq == 0) ssq16[(size_t)row * 16 + u.pn * 4 + wc] = ss;
            }
    }
};
template <bool INF32, bool OUTF32>
struct EpiResB {
    static constexpr bool PERM = true, AFTER_DRAIN = false;
    const float* Xin; float* Xout; bf16_t* XB; float* ssq16; float scale;
    __device__ __forceinline__ void operator()(const f32x4 (&acc)[2][2][4][2], const Unit& u, int wr, int wc, int fr, int fq) const {
#pragma unroll
        for (int ai = 0; ai < 2; ++ai)
#pragma unroll
            for (int m = 0; m < 4; ++m) {
                const int row = u.pm * BM + ai * HALF + wr * 64 + m * 16 + fr;
                float ss = 0.f;
#pragma unroll
                for (int bj = 0; bj < 2; ++bj) {
                    const int col0 = u.pn * BM + bj * HALF + wc * 32 + 8 * fq;
                    f32x4 x0, x1;
                    if (INF32) { const float* pi = Xin + (size_t)row * 1024 + col0; x0 = *(const f32x4*)pi; x1 = *(const f32x4*)(pi + 4); }
                    else {
                        const u32x4 w = *(const u32x4*)(XB + (size_t)row * 1024 + col0);
                        x0 = (f32x4){__uint_as_float(w.x << 16), __uint_as_float(w.x & 0xffff0000u), __uint_as_float(w.y << 16), __uint_as_float(w.y & 0xffff0000u)};
                        x1 = (f32x4){__uint_as_float(w.z << 16), __uint_as_float(w.z & 0xffff0000u), __uint_as_float(w.w << 16), __uint_as_float(w.w & 0xffff0000u)};
                    }
                    x0 = x0 + acc[ai][bj][m][0] * scale; x1 = x1 + acc[ai][bj][m][1] * scale;
                    ss += ((x0[0] * x0[0] + x0[1] * x0[1]) + (x0[2] * x0[2] + x0[3] * x0[3])) + ((x1[0] * x1[0] + x1[1] * x1[1]) + (x1[2] * x1[2] + x1[3] * x1[3]));
                    if (OUTF32) { float* px = Xout + (size_t)row * 1024 + col0; *(f32x4*)px = x0; *(f32x4*)(px + 4) = x1; }
                    else {
                        u32x4 w; w.x = cvt_pk_bf16(x0[0], x0[1]); w.y = cvt_pk_bf16(x0[2], x0[3]); w.z = cvt_pk_bf16(x1[0], x1[1]); w.w = cvt_pk_bf16(x1[2], x1[3]);
                        *(u32x4*)(XB + (size_t)row * 1024 + col0) = w;
                    }
                }
                ss += __shfl_xor(ss, 16); ss += __shfl_xor(ss, 32);
                if (fq == 0) ssq16[(size_t)row * 16 + u.pn * 4 + wc] = ss;
            }
    }
};
struct EpiZ {
    static constexpr bool PERM = true, AFTER_DRAIN = false;
    const float* ssq16; bf16_t* Z; int ldz;
    __device__ __forceinline__ void operator()(const f32x4 (&acc)[2][2][4][2], const Unit& u, int wr, int wc, int fr, int fq) const {
#pragma unroll
        for (int ai = 0; ai < 2; ++ai)
#pragma unroll
            for (int m = 0; m < 4; ++m) {
                const int row = u.pm * BM + ai * HALF + wr * 64 + m * 16 + fr;
                const float rs = rstd16(ssq16, row);
#pragma unroll
                for (int bj = 0; bj < 2; ++bj) {
                    const int col0 = u.pn * BM + bj * HALF + wc * 32 + 8 * fq;
                    const f32x4 v0 = acc[ai][bj][m][0] * rs, v1 = acc[ai][bj][m][1] * rs;
                    u32x4 w; w.x = cvt_pk_bf16(v0[0], v0[1]); w.y = cvt_pk_bf16(v0[2], v0[3]); w.z = cvt_pk_bf16(v1[0], v1[1]); w.w = cvt_pk_bf16(v1[2], v1[3]);
                    *(u32x4*)(Z + (size_t)row * ldz + col0) = w;
                }
            }
    }
};
template <class Epi, class Sched, bool ALIGN_EPI = false, bool SP2 = false, bool LDAK = true>
__device__ __forceinline__ void gemm_phase(PG8_LAS unsigned char* lds, const Gemm g, const Sched& S, const Epi& E) {
    const int tid = tidx(), wid = __builtin_amdgcn_readfirstlane(tid >> 6), lane = tid & 63, wr = wid >> 2, wc = wid & 3, fr = lane & 15, fq = lane >> 4;
    const int K = g.K, nt = K / BK;
    unsigned voffA[2], voffB[2];
#pragma unroll
    for (int i = 0; i < 2; ++i) { int R, C; stage_rc(tid * 16 + i * 8192, R, C); const int Rb = Epi::PERM ? ((R & ~31) + perm32(R & 31)) : R;
        voffA[i] = (unsigned)(R * (LDAK ? K : g.lda) + C) * 2u; voffB[i] = (unsigned)(Rb * K + C) * 2u; }
    const size_t kstep = (size_t)(BK * 2);
    const size_t hstep = (size_t)HALF * K * 2;
    const size_t tstep = 2 * hstep;
    const size_t hstepA = LDAK ? hstep : (size_t)HALF * g.lda * 2, tstepA = 2 * hstepA;
    const unsigned ldsw = (unsigned)wid * 1024u;
    const int aoff = lds_byte(wr * 64 + fr, fq * 8), boff = lds_byte(wc * 32 + fr, fq * 8);
#define PG8_SA(b, h) (((b) * 2 + (h)) * HTB)
#define PG8_SB(b, h) ((4 + (b) * 2 + (h)) * HTB)
#define PG8_STAGE(bufoff, gbase, voff) do { _Pragma("unroll") for (int _i = 0; _i < 2; ++_i) \
        __builtin_amdgcn_global_load_lds((const unsigned*)((const char*)(gbase) + (voff)[_i]), (PG8_LAS unsigned*)(lds + (bufoff) + ldsw + _i * 8192), 16, 0, 0); } while (0)
#define PG8_LDA(dst, b, h) do { _Pragma("unroll") for (int m = 0; m < 4; ++m) _Pragma("unroll") for (int k = 0; k < 2; ++k) dst[m][k] = *(const PG8_LAS bf16x8*)(lds + PG8_SA(b, h) + aoff + m * 2048 + k * 1024); } while (0)
#define PG8_LDB(dst, b, h) do { _Pragma("unroll") for (int n = 0; n < 2; ++n) _Pragma("unroll") for (int k = 0; k < 2; ++k) dst[n][k] = *(const PG8_LAS bf16x8*)(lds + PG8_SB(b, h) + boff + n * 2048 + k * 1024); } while (0)
#define PG8_MMA(ai, bj, At, Bt) do { __builtin_amdgcn_s_setprio(1); _Pragma("unroll") for (int m = 0; m < 4; ++m) _Pragma("unroll") for (int n = 0; n < 2; ++n) _Pragma("unroll") for (int k = 0; k < 2; ++k) \
        acc[ai][bj][m][n] = __builtin_amdgcn_mfma_f32_16x16x32_bf16(Bt[n][k], At[m][k], acc[ai][bj][m][n], 0, 0, 0); __builtin_amdgcn_s_setprio(0); } while (0)
#define PG8_WAIT_V(n) asm volatile("s_waitcnt vmcnt(" #n ")" ::: "memory")
#define PG8_WAIT_L(n) asm volatile("s_waitcnt lgkmcnt(" #n ")" ::: "memory")
#define PG8_BAR __builtin_amdgcn_s_barrier()
#define PG8_SCHED __builtin_amdgcn_sched_barrier(0)
    Unit cur, nxt; int ui = 0;
    if (!S.next(0, cur)) return;
    f32x4 acc[2][2][4][2];
#pragma unroll
    for (int a = 0; a < 2; ++a)
#pragma unroll
        for (int b = 0; b < 2; ++b)
#pragma unroll
            for (int m = 0; m < 4; ++m)
#pragma unroll
                for (int n = 0; n < 2; ++n) acc[a][b][m][n] = (f32x4){0.f, 0.f, 0.f, 0.f};
    bf16x8 At[4][2], B0[2][2], B1[2][2];
    const char* cA = (const char*)g.A + (size_t)cur.pm * tstepA; const char* cB = (const char*)g.Bt + (size_t)cur.pn * tstep;
    S.a_ready(cur);
    if constexpr (SP2) {
        PG8_STAGE(PG8_SB(0, 0), cB, voffB); PG8_STAGE(PG8_SB(0, 1), cB + hstep, voffB); PG8_STAGE(PG8_SA(0, 0), cA, voffA); PG8_STAGE(PG8_SA(0, 1), cA + hstepA, voffA);
        if (wr == 1) PG8_BAR;
        PG8_WAIT_V(2); PG8_BAR;
        PG8_STAGE(PG8_SB(1, 0), cB + kstep, voffB); PG8_STAGE(PG8_SA(1, 0), cA + kstep, voffA); PG8_STAGE(PG8_SB(1, 1), cB + hstep + kstep, voffB);
        PG8_WAIT_V(6); PG8_BAR;
    } else {
        PG8_STAGE(PG8_SB(0, 0), cB, voffB); PG8_STAGE(PG8_SA(0, 0), cA, voffA); PG8_STAGE(PG8_SB(0, 1), cB + hstep, voffB); PG8_STAGE(PG8_SA(0, 1), cA + hstepA, voffA);
        if (wr == 1) PG8_BAR;
        PG8_WAIT_V(4); PG8_BAR;
        PG8_STAGE(PG8_SB(1, 0), cB + kstep, voffB); PG8_STAGE(PG8_SA(1, 0), cA + kstep, voffA); PG8_STAGE(PG8_SB(1, 1), cB + hstep + kstep, voffB);
        PG8_WAIT_V(6); PG8_BAR;
    }
    for (;;) {
        const bool has_next = S.next(ui + 1, nxt);
        const char* nA = has_next ? (const char*)g.A + (size_t)nxt.pm * tstepA : cA; const char* nB = has_next ? (const char*)g.Bt + (size_t)nxt.pn * tstep : cB;
        for (int t = 0; t < nt; t += 2) {
            const bool last = (t == nt - 2);
            const char* a1 = cA + (size_t)(t + 1) * kstep;
            const char* a2 = last ? nA : cA + (size_t)(t + 2) * kstep; const char* b2 = last ? nB : cB + (size_t)(t + 2) * kstep;
            const char* a3 = a2 + kstep; const char* b3 = b2 + kstep;
            if (last && has_next) S.a_ready(nxt);
            if constexpr (SP2) {
            PG8_LDB(B0, 0, 0); PG8_LDB(B1, 0, 1); PG8_SCHED; PG8_LDA(At, 0, 0); PG8_STAGE(PG8_SA(1, 1), a1 + hstepA, voffA);
            PG8_WAIT_V(8); PG8_WAIT_L(0); PG8_BAR; PG8_MMA(0, 0, At, B0); PG8_MMA(0, 1, At, B1); PG8_BAR; PG8_SCHED;
            PG8_LDA(At, 0, 1); PG8_STAGE(PG8_SB(0, 0), b2, voffB); PG8_STAGE(PG8_SB(0, 1), b2 + hstep, voffB); PG8_STAGE(PG8_SA(0, 0), a2, voffA);
            PG8_WAIT_V(8); PG8_WAIT_L(0); PG8_BAR; PG8_MMA(1, 0, At, B0); PG8_MMA(1, 1, At, B1); PG8_BAR; PG8_SCHED;
            PG8_LDB(B0, 1, 0); PG8_LDB(B1, 1, 1); PG8_SCHED; PG8_LDA(At, 1, 0); PG8_STAGE(PG8_SA(0, 1), a2 + hstepA, voffA);
            PG8_WAIT_V(8); PG8_WAIT_L(0); PG8_BAR; PG8_MMA(0, 0, At, B0); PG8_MMA(0, 1, At, B1); PG8_BAR; PG8_SCHED;
            PG8_LDA(At, 1, 1); PG8_STAGE(PG8_SB(1, 0), b3, voffB); PG8_STAGE(PG8_SB(1, 1), b3 + hstep, voffB); PG8_STAGE(PG8_SA(1, 0), a3, voffA);
            PG8_WAIT_V(8); PG8_WAIT_L(0); PG8_BAR; PG8_MMA(1, 0, At, B0); PG8_MMA(1, 1, At, B1); PG8_BAR; PG8_SCHED;
            } else {
            PG8_LDB(B0, 0, 0); PG8_SCHED; PG8_LDA(At, 0, 0); PG8_STAGE(PG8_SA(1, 1), a1 + hstepA, voffA);
            PG8_WAIT_L(8); PG8_BAR; PG8_WAIT_L(0); PG8_MMA(0, 0, At, B0); PG8_BAR; PG8_SCHED;
            PG8_LDB(B1, 0, 1); PG8_STAGE(PG8_SB(0, 0), b2, voffB);
            PG8_BAR; PG8_WAIT_L(0); PG8_MMA(0, 1, At, B1); PG8_BAR;
            PG8_LDA(At, 0, 1); PG8_STAGE(PG8_SA(0, 0), a2, voffA);
            PG8_BAR; PG8_WAIT_L(0); PG8_MMA(1, 0, At, B0); PG8_BAR; PG8_SCHED;
            PG8_STAGE(PG8_SB(0, 1), b2 + hstep, voffB);
            PG8_WAIT_V(6); PG8_BAR; PG8_MMA(1, 1, At, B1); PG8_BAR;
            PG8_LDB(B0, 1, 0); PG8_SCHED; PG8_LDA(At, 1, 0); PG8_STAGE(PG8_SA(0, 1), a2 + hstepA, voffA);
            PG8_WAIT_L(8); PG8_BAR; PG8_WAIT_L(0); PG8_MMA(0, 0, At, B0); PG8_BAR; PG8_SCHED;
            PG8_LDB(B1, 1, 1); PG8_STAGE(PG8_SB(1, 0), b3, voffB);
            PG8_BAR; PG8_WAIT_L(0); PG8_MMA(0, 1, At, B1); PG8_BAR;
            PG8_LDA(At, 1, 1); PG8_STAGE(PG8_SA(1, 0), a3, voffA);
            PG8_BAR; PG8_WAIT_L(0); PG8_MMA(1, 0, At, B0); PG8_BAR; PG8_SCHED;
            PG8_STAGE(PG8_SB(1, 1), b3 + hstep, voffB);
            PG8_WAIT_V(6); PG8_BAR; PG8_MMA(1, 1, At, B1); PG8_BAR;
            }
        }
        if constexpr (ALIGN_EPI) { if (wr == 0) PG8_BAR; }
        if constexpr (!Epi::AFTER_DRAIN) { E(acc, cur, wr, wc, fr, fq); S.done(cur); }
        if (!has_next) break;
#pragma unroll
        for (int a = 0; a < 2; ++a)
#pragma unroll
            for (int b = 0; b < 2; ++b)
#pragma unroll
                for (int m = 0; m < 4; ++m)
#pragma unroll
                    for (int n = 0; n < 2; ++n) acc[a][b][m][n] = (f32x4){0.f, 0.f, 0.f, 0.f};
        cur = nxt; cA = nA; cB = nB; ++ui;
        if constexpr (ALIGN_EPI) { if (wr == 1) PG8_BAR; }
    }
    PG8_WAIT_V(0);
    if constexpr (!ALIGN_EPI) { if (wr == 0) PG8_BAR; }
    PG8_BAR;
    if constexpr (Epi::AFTER_DRAIN) { E.fused(acc, cur, wr, wc, fr, fq, lds, wid, lane); S.done(cur); }
#undef PG8_SA
#undef PG8_SB
#undef PG8_STAGE
#undef PG8_LDA
#undef PG8_LDB
#undef PG8_MMA
#undef PG8_WAIT_V
#undef PG8_WAIT_L
#undef PG8_BAR
#undef PG8_SCHED
}
}

#define WAVE_SYNC() asm volatile("s_waitcnt vmcnt(0) lgkmcnt(0)" ::: "memory")
__device__ __forceinline__ float bf2f(bf16_t v) { return __uint_as_float(((unsigned)v) << 16); }
__device__ __forceinline__ bf16_t f2bf(float f) { unsigned u = __float_as_uint(f); return (bf16_t)((u + 0x7fffu + ((u >> 16) & 1u)) >> 16); }
__device__ __forceinline__ float sigmoidf_(float x) { return 1.f / (1.f + expf(-x)); }
__device__ __forceinline__ float siluf_(float x) { return x * sigmoidf_(x); }
__device__ __forceinline__ float gelu_tanh(float x) { const float x3 = x * x * x; return 0.5f * x * (1.f + tanhf(0.7978845608028654f * (x + 0.044715f * x3))); }
__device__ __forceinline__ float wave_sum(float v) {
#pragma unroll
    for (int o = 1; o < 64; o <<= 1) v += __shfl_xor(v, o);
    return v;
}
__device__ __forceinline__ float wave_max(float v) {
#pragma unroll
    for (int o = 1; o < 64; o <<= 1) v = fmaxf(v, __shfl_xor(v, o));
    return v;
}
__device__ __forceinline__ int t5_bucket(int n) {
    if (n < 16) return n;
    const float v = logf((float)n / 16.f) / 4.1588830833596715f * 16.f;
    int b = 16 + (int)v;
    return b < 31 ? b : 31;
}
__device__ __forceinline__ float rstd_of(const float* ssq, int r) { return pg8::rstd16(ssq, r); }

__device__ __forceinline__ void cw_item(const float* W, int K, int N, const float* gain, bf16_t* Bt, int rs, int ro, float* scr, int item, int lane) {
    const int nblk = (N + 31) >> 5, kb = item / nblk, nbk = item - kb * nblk, k0 = 64 * kb, n0 = 32 * nbk;
    const int nn = n0 + (lane & 31); const bool nok = nn < N;
    float v[32];
    const float* wp = W + (size_t)(k0 + (lane >> 5)) * N + nn;
#pragma unroll
    for (int i = 0; i < 32; ++i) v[i] = nok ? wp[(size_t)(2 * i) * N] : 0.f;
    if (gain) {
#pragma unroll
        for (int i = 0; i < 32; ++i) v[i] *= gain[k0 + 2 * i + (lane >> 5)];
    }
#pragma unroll
    for (int i = 0; i < 32; ++i) scr[(2 * i + (lane >> 5)) * 33 + (lane & 31)] = v[i];
    WAVE_SYNC();
    const int c = lane & 7;
#pragma unroll
    for (int j = 0; j < 4; ++j) {
        const int n = (lane >> 3) + 8 * j; const float* sp = scr + (8 * c) * 33 + n;
        pg8::u32x4 o; o.x = pg8::cvt_pk_bf16(sp[0], sp[33]); o.y = pg8::cvt_pk_bf16(sp[66], sp[99]); o.z = pg8::cvt_pk_bf16(sp[132], sp[165]); o.w = pg8::cvt_pk_bf16(sp[198], sp[231]);
        const int nn2 = n0 + n, drow = rs ? (nn2 * rs + ro) : (((nn2 >> 7) << 8) + (nn2 & 127) + ro);
        if (nn2 < N) *(pg8::u32x4*)(Bt + (size_t)drow * K + k0 + 8 * c) = o;
    }
    WAVE_SYNC();
}
__device__ __forceinline__ void convert_wt(const float* W, int K, int N, const float* gain, bf16_t* Bt, int rs, int ro, float* lds, int& g, int NGW) {
    const int lane = tidx() & 63, wave = tidx() >> 6;
    const int nitems = (K >> 6) * ((N + 31) >> 5);
    float* scr = lds + wave * (64 * 33);
    while (g < nitems) { cw_item(W, K, N, gain, Bt, rs, ro, scr, g, lane); g += NGW; }
    g -= nitems;
}

__device__ __forceinline__ void rowstats(const float* src, float* X, bf16_t* XB, float* SSQ, int bid, int nb) {
    const int wave = tidx() >> 6, lane = tidx() & 63;
    for (int r = bid * NWAVE + wave; r < MTOK; r += nb * NWAVE) {
        float s = 0.f;
#pragma unroll
        for (int j = 0; j < 4; ++j) {
            const f32x4 v = *(const f32x4*)(src + (size_t)r * DM + j * 256 + lane * 4);
            s += (v.x * v.x + v.y * v.y) + (v.z * v.z + v.w * v.w);
            if (X != src) *(f32x4*)(X + (size_t)r * DM + j * 256 + lane * 4) = v;
            ushort4 o; o.x = f2bf(v.x); o.y = f2bf(v.y); o.z = f2bf(v.z); o.w = f2bf(v.w);
            *(ushort4*)(XB + (size_t)r * DM + j * 256 + lane * 4) = o;
        }
        s = wave_sum(s);
        if (lane < 16) SSQ[16 * (size_t)r + lane] = (lane == 0) ? s : 0.f;
    }
}

template <class Epi>
__device__ __forceinline__ void gemm_naive(const bf16_t* A, int lda, const bf16_t* Bt, int ldb, int Mrows, int N, int K, float* lds, int bid, int nb, Epi epi) {
    const int tid = tidx(), tx = tid & 31, ty = tid >> 5;
    float* As = lds;
    float* Bs = lds + 16 * 132;
    const int tn_n = N / 128, ntiles = (Mrows / 128) * tn_n;
    for (int tile = bid; tile < ntiles; tile += nb) {
        const int tm = tile / tn_n, tn = tile % tn_n;
        float acc[8][4];
#pragma unroll
        for (int i = 0; i < 8; ++i)
#pragma unroll
            for (int j = 0; j < 4; ++j) acc[i][j] = 0.f;
        const int lr = tid >> 2, lk = (tid & 3) * 4;
        const bf16_t* ap = A + (size_t)(tm * 128 + lr) * lda + lk;
        const bf16_t* bp = Bt + (size_t)(tn * 128 + lr) * ldb + lk;
        for (int k0 = 0; k0 < K; k0 += 16) {
            const ushort4 av = *(const ushort4*)(ap + k0);
            const ushort4 bv = *(const ushort4*)(bp + k0);
            __syncthreads();
            As[(lk + 0) * 132 + lr] = bf2f(av.x); As[(lk + 1) * 132 + lr] = bf2f(av.y); As[(lk + 2) * 132 + lr] = bf2f(av.z); As[(lk + 3) * 132 + lr] = bf2f(av.w);
            Bs[(lk + 0) * 132 + lr] = bf2f(bv.x); Bs[(lk + 1) * 132 + lr] = bf2f(bv.y); Bs[(lk + 2) * 132 + lr] = bf2f(bv.z); Bs[(lk + 3) * 132 + lr] = bf2f(bv.w);
            __syncthreads();
#pragma unroll 2
            for (int kk = 0; kk < 16; ++kk) {
                const f32x4 a0 = *(const f32x4*)(As + kk * 132 + ty * 8), a1 = *(const f32x4*)(As + kk * 132 + ty * 8 + 4);
                const f32x4 b = *(const f32x4*)(Bs + kk * 132 + tx * 4);
                const float a[8] = {a0.x, a0.y, a0.z, a0.w, a1.x, a1.y, a1.z, a1.w};
#pragma unroll
                for (int i = 0; i < 8; ++i) { acc[i][0] += a[i] * b.x; acc[i][1] += a[i] * b.y; acc[i][2] += a[i] * b.z; acc[i][3] += a[i] * b.w; }
            }
        }
#pragma unroll
        for (int i = 0; i < 8; ++i) epi(tm * 128 + ty * 8 + i, tn * 128 + tx * 4, acc[i]);
    }
}

struct EpiGU { const float* ssq; bf16_t* H;
    __device__ __forceinline__ void operator()(int r, int c, const float* a) const {
        const float rs = rstd_of(ssq, r);
        const float h0 = siluf_(a[0] * rs) * (a[1] * rs), h1 = siluf_(a[2] * rs) * (a[3] * rs);
        ushort2 o; o.x = f2bf(h0); o.y = f2bf(h1);
        *(ushort2*)(H + (size_t)r * DFF + (c >> 1)) = o; } };
struct EpiResid { float* X; float scale;
    __device__ __forceinline__ void operator()(int r, int c, const float* a) const {
        f32x4* p = (f32x4*)(X + (size_t)r * DM + c); f32x4 v = *p;
        v.x += scale * a[0]; v.y += scale * a[1]; v.z += scale * a[2]; v.w += scale * a[3]; *p = v; } };
struct EpiZ { const float* ssq; bf16_t* Z;
    __device__ __forceinline__ void operator()(int r, int c, const float* a) const {
        const float rs = rstd_of(ssq, r);
        ushort4 o; o.x = f2bf(a[0] * rs); o.y = f2bf(a[1] * rs); o.z = f2bf(a[2] * rs); o.w = f2bf(a[3] * rs);
        *(ushort4*)(Z + (size_t)r * ZLD + c) = o; } };

__device__ __forceinline__ void s5_tables(const Params& p, int l, float* tab  , int gtid, int gthreads) {
    const float* lam_re = p.in[8] + l * 1024; const float* lam_im = p.in[9] + l * 1024; const float* log_dt = p.in[10] + l * 16;
    const float* b_re = p.in[11] + l * 16384; const float* b_im = p.in[12] + l * 16384;
    for (int i = gtid; i < 16384; i += gthreads) {
        const int gp = i >> 4;
        const int g = gp >> 6;
        const float lr = lam_re[gp], li = lam_im[gp], dt = expf(log_dt[g]);
        const float mag = expf(lr * dt), are = mag * cosf(li * dt), aim = mag * sinf(li * dt);
        const float den = lr * lr + li * li, nr = are - 1.f, ni = aim;
        const float gre = (nr * lr + ni * li) / den, gim = (ni * lr - nr * li) / den;
        const float br = b_re[i], bi = b_im[i];
        tab[2048 + i] = gre * br - gim * bi;
        tab[2048 + 16384 + i] = gre * bi + gim * br;
        if ((i & 15) == 0) { tab[gp] = are; tab[1024 + gp] = aim; }
    }
}

__device__ __forceinline__ void s5_scan_naive(const Params& p, int l, const bf16_t* Z, float* S5PRE, const float* tab, float* lds, int item  ) {
    const int lane = tidx() & 63;
    const int b = item >> 4, g = item & 15;
    const float* c_re = p.in[13] + l * 16384 + g * 1024;
    const float* c_im = p.in[14] + l * 16384 + g * 1024;
    const float* dsk = p.in[15] + l * 256 + g * 16;
    float* us = lds;
    float* xr = lds + 1024;
    float* xi = xr + 64 * 65;
    float* cre = xi + 64 * 65;
    float* cim = cre + 1024;
    const float are = tab[g * 64 + lane], aim = tab[1024 + g * 64 + lane];
    float bbr[16], bbi[16];
#pragma unroll
    for (int h = 0; h < 16; ++h) { bbr[h] = tab[2048 + (g * 64 + lane) * 16 + h]; bbi[h] = tab[2048 + 16384 + (g * 64 + lane) * 16 + h]; }
    for (int i = lane; i < 1024; i += 64) { cre[i] = c_re[i]; cim[i] = c_im[i]; }
    float sr = 0.f, si = 0.f;
    for (int t0 = 0; t0 < SEQ; t0 += 64) {
        {
            const bf16_t* zp = Z + (size_t)(b * SEQ + t0 + lane) * ZLD + ZC_U + g * 16;
#pragma unroll
            for (int h = 0; h < 16; ++h) us[lane * 16 + h] = bf2f(zp[h]);
        }
        WAVE_SYNC();
        for (int s = 0; s < 64; ++s) {
            float bur = 0.f, bui = 0.f;
#pragma unroll
            for (int h = 0; h < 16; ++h) { const float u = us[s * 16 + h]; bur += u * bbr[h]; bui += u * bbi[h]; }
            const float nr = are * sr - aim * si + bur, ni = are * si + aim * sr + bui;
            sr = nr; si = ni;
            xr[s * 65 + lane] = sr; xi[s * 65 + lane] = si;
        }
        WAVE_SYNC();
        {
            float y[16];
#pragma unroll
            for (int h = 0; h < 16; ++h) y[h] = dsk[h] * us[lane * 16 + h];
            for (int pp = 0; pp < 64; ++pp) {
                const float a = xr[lane * 65 + pp], bq = xi[lane * 65 + pp];
#pragma unroll
                for (int h = 0; h < 16; ++h) y[h] += a * cre[h * 64 + pp] - bq * cim[h * 64 + pp];
            }
            float* o = S5PRE + (size_t)(b * SEQ + t0 + lane) * 256 + g * 16;
#pragma unroll
            for (int h = 0; h < 16; ++h) o[h] = y[h];
        }
        WAVE_SYNC();
    }
}

__device__ __forceinline__ void s5_post_naive(const Params& p, int l, const float* S5PRE, bf16_t* Y, float* lds, int bid, int nb) {
    const float* wglu = p.in[16] + l * 65536;
    const int tid = tidx(), half = tid >> 8, j = tid & 255;
    for (int r0 = bid * 2; r0 < MTOK; r0 += nb * 2) {
        __syncthreads();
        lds[tid] = gelu_tanh(S5PRE[(size_t)(r0 + half) * 256 + j]);
        __syncthreads();
        const float* yg = lds + half * 256;
        float acc = 0.f;
        for (int i = 0; i < 256; ++i) acc += yg[i] * wglu[i * 256 + j];
        Y[(size_t)(r0 + half) * DM + j] = f2bf(yg[j] * sigmoidf_(acc));
    }
}

__device__ __forceinline__ void hgrn_naive(const Params& p, int l, const bf16_t* Z, bf16_t* Y, const float* LB, float* lds, int item  ) {
    const int lane = tidx() & 63;
    const int b = item >> 2, h = item & 3;
    const float lb = LB[l * 256 + h * 64 + lane];
    const float gain = p.in[18][l * 64 + lane];
    float* qs = lds;
    float* fs = qs + 4096;
    float* ks = fs + 4096;
    float* vs = ks + 4096;
    float* gs = vs + 4096;
    float S[64];
#pragma unroll
    for (int d = 0; d < 64; ++d) S[d] = 0.f;
    for (int t0 = 0; t0 < SEQ; t0 += 64) {
        for (int s = 0; s < 64; ++s) {
            const bf16_t* zp = Z + (size_t)(b * SEQ + t0 + s) * ZLD + h * 64 + lane;
            const float q = bf2f(zp[ZC_HQ]), fl = bf2f(zp[ZC_HF]), iv = bf2f(zp[ZC_HI]), gv = bf2f(zp[ZC_HG]);
            qs[s * 64 + lane] = siluf_(q);
            fs[s * 64 + lane] = lb + (1.f - lb) * sigmoidf_(fl);
            ks[s * 64 + lane] = (1.f - lb) * sigmoidf_(-fl);
            vs[s * 64 + lane] = iv;
            gs[s * 64 + lane] = gv;
        }
        WAVE_SYNC();
        for (int s = 0; s < 64; ++s) {
            const float v = vs[s * 64 + lane];
            float o = 0.f;
#pragma unroll
            for (int d = 0; d < 64; d += 4) {
                const f32x4 f4 = *(const f32x4*)(fs + s * 64 + d), k4 = *(const f32x4*)(ks + s * 64 + d), q4 = *(const f32x4*)(qs + s * 64 + d);
                S[d] = f4.x * S[d] + k4.x * v; o += q4.x * S[d];
                S[d + 1] = f4.y * S[d + 1] + k4.y * v; o += q4.y * S[d + 1];
                S[d + 2] = f4.z * S[d + 2] + k4.z * v; o += q4.z * S[d + 2];
                S[d + 3] = f4.w * S[d + 3] + k4.w * v; o += q4.w * S[d + 3];
            }
            const float ms = wave_sum(o * o) * (1.f / 64.f);
            const float on = o * rsqrtf(ms + EPS) * gain * siluf_(gs[s * 64 + lane]);
            Y[(size_t)(b * SEQ + t0 + s) * DM + 256 + h * 64 + lane] = f2bf(on);
        }
        WAVE_SYNC();
    }
}

__device__ __forceinline__ void nsa_compress_naive(const Params& p, int l, const bf16_t* Z, bf16_t* KC, bf16_t* VC, float* lds_wave, int item) {
    const int lane = tidx() & 63;
    const int kv = item & 1, g = (item >> 1) & 1, rest = item >> 2, n = rest % NCMP, b = rest / NCMP;
    const float* pos = p.in[kv ? 22 : 19] + l * 2048;
    const float* w1 = p.in[kv ? 23 : 20] + (size_t)l * 131072;
    const float* w2 = p.in[kv ? 24 : 21] + l * 4096;
    const bf16_t* zp = Z + (size_t)(b * SEQ + 16 * n) * ZLD + ZC_NKV + kv * 128 + g * 64;
    float hsum = 0.f;
    for (int j = 0; j < 32; ++j) {
        const float xv = bf2f(zp[(size_t)j * ZLD + lane]) + pos[j * 64 + lane];
        for (int d = 0; d < 64; ++d) {
            const float xd = __shfl(xv, d);
            hsum += xd * w1[(size_t)(j * 64 + d) * 64 + lane];
        }
    }
    lds_wave[lane] = gelu_tanh(hsum);
    WAVE_SYNC();
    float o = 0.f;
    for (int m = 0; m < 64; ++m) o += lds_wave[m] * w2[m * 64 + lane];
    (kv ? VC : KC)[((size_t)(b * 2 + g) * 512 + n) * 64 + lane] = f2bf(o);
    if (n == 0) (kv ? VC : KC)[((size_t)(b * 2 + g) * 512 + 511) * 64 + lane] = 0;
    WAVE_SYNC();
}

__device__ __forceinline__ void nsa_attn_naive(const bf16_t* Z, const float* KC, const float* VC, bf16_t* Y, const float* btab, float* lw, int item) {
    const int lane = tidx() & 63;
    const int g = item & 1, bt = item >> 1, b = bt / SEQ, t = bt % SEQ;
    float* qs = lw;
    float* pc = lw + 256;
    float* pl = pc + 2048;
    int* sel = (int*)(pl + 256);
    const bf16_t* zrow = Z + (size_t)bt * ZLD;
#pragma unroll
    for (int r = 0; r < 4; ++r) qs[r * 64 + lane] = bf2f(zrow[ZC_NQ + g * 256 + r * 64 + lane]);
    for (int i = lane; i < 2048; i += 64) pc[i] = 0.f;
    WAVE_SYNC();
    const float* bt_g = btab + (g * 4) * 1024;
    float ocmp[4] = {0.f, 0.f, 0.f, 0.f};
    const int nval = t >= 31 ? min((t - 31) / 16 + 1, NCMP) : 0;
    if (nval > 0) {
        const float* kc = KC + (size_t)(b * 2 + g) * 512 * 64;
        const float* vc = VC + (size_t)(b * 2 + g) * 512 * 64;
        for (int i = 0; i < 8; ++i) {
            const int c = lane + 64 * i;
            float a0 = -1e30f, a1 = -1e30f, a2 = -1e30f, a3 = -1e30f;
            if (c < nval) {
                const float* kr = kc + c * 64;
                a0 = 0.f; a1 = 0.f; a2 = 0.f; a3 = 0.f;
#pragma unroll 4
                for (int d = 0; d < 64; ++d) { const float kd = kr[d]; a0 += qs[d] * kd; a1 += qs[64 + d] * kd; a2 += qs[128 + d] * kd; a3 += qs[192 + d] * kd; }
                const int dist = min(t - (16 * c + 31), 1023);
                a0 = a0 * 0.125f + bt_g[dist]; a1 = a1 * 0.125f + bt_g[1024 + dist]; a2 = a2 * 0.125f + bt_g[2048 + dist]; a3 = a3 * 0.125f + bt_g[3072 + dist];
            }
            pc[c] = a0; pc[512 + c] = a1; pc[1024 + c] = a2; pc[1536 + c] = a3;
        }
        for (int r = 0; r < 4; ++r) {
            float m = -1e30f;
            for (int i = 0; i < 8; ++i) m = fmaxf(m, pc[r * 512 + lane + 64 * i]);
            m = wave_max(m);
            float sum = 0.f;
            for (int i = 0; i < 8; ++i) { const int c = lane + 64 * i; const float e = (c < nval) ? expf(pc[r * 512 + c] - m) : 0.f; pc[r * 512 + c] = e; sum += e; }
            sum = wave_sum(sum);
            const float inv = 1.f / fmaxf(sum, 1e-30f);
            for (int i = 0; i < 8; ++i) pc[r * 512 + lane + 64 * i] *= inv;
        }
        WAVE_SYNC();
        for (int c = 0; c < nval; ++c) {
            const float v = vc[c * 64 + lane];
            ocmp[0] += pc[c] * v; ocmp[1] += pc[512 + c] * v; ocmp[2] += pc[1024 + c] * v; ocmp[3] += pc[1536 + c] * v;
        }
    }
    {
        float sc[2];
#pragma unroll
        for (int q = 0; q < 2; ++q) {
            const int j = lane + 64 * q;
            float ps = 0.f;
#pragma unroll
            for (int e = -1; e <= 3; ++e) {
                const int c = 4 * j + e;
                if (c >= 0 && c < NCMP) { const float im = (pc[c] + pc[512 + c]) + (pc[1024 + c] + pc[1536 + c]); ps += (e == -1 || e == 3) ? im : 2.f * im; }
            }
            const int cur = t >> 6;
            const bool ok = (j * 64) <= t, forced = (j == 0) || (j == cur) || (j == cur - 1);
            sc[q] = ok ? ps + (forced ? 1e4f : 0.f) : -1e30f;
        }
        for (int it = 0; it < 16; ++it) {
            float bv; int bi;
            if (sc[0] >= sc[1]) { bv = sc[0]; bi = lane; } else { bv = sc[1]; bi = lane + 64; }
#pragma unroll
            for (int o = 1; o < 64; o <<= 1) {
                const float ov = __shfl_xor(bv, o); const int oi = __shfl_xor(bi, o);
                if (ov > bv || (ov == bv && oi < bi)) { bv = ov; bi = oi; }
            }
            if (lane == 0) sel[it] = bi;
            if (bi == lane) sc[0] = -3e38f;
            if (bi == lane + 64) sc[1] = -3e38f;
        }
        WAVE_SYNC();
    }
    float obr[2][4];
#pragma unroll
    for (int br = 0; br < 2; ++br) {
        float m[4] = {-1e30f, -1e30f, -1e30f, -1e30f}, lsum[4] = {0.f, 0.f, 0.f, 0.f}, o[4] = {0.f, 0.f, 0.f, 0.f};
        const int kcol = ZC_NKV + (br ? 4 : 2) * 128 + g * 64, vcol = kcol + 128;
        const int nblk = br ? 8 : 16;
        for (int ib = 0; ib < nblk; ++ib) {
            const int p0 = br ? (t - 511 + 64 * ib) : sel[ib] * 64;
            if (p0 > t || p0 + 63 < 0) continue;
            const int pos = p0 + lane;
            const bool valid = pos >= 0 && pos <= t;
            float s4[4] = {0.f, 0.f, 0.f, 0.f};
            if (valid) {
                const bf16_t* kr = Z + (size_t)(b * SEQ + pos) * ZLD + kcol;
                for (int d = 0; d < 64; d += 4) {
                    const ushort4 k4 = *(const ushort4*)(kr + d);
                    const float k0 = bf2f(k4.x), k1 = bf2f(k4.y), k2 = bf2f(k4.z), k3 = bf2f(k4.w);
#pragma unroll
                    for (int r = 0; r < 4; ++r) s4[r] += qs[r * 64 + d] * k0 + qs[r * 64 + d + 1] * k1 + qs[r * 64 + d + 2] * k2 + qs[r * 64 + d + 3] * k3;
                }
                const int dist = min(t - pos, 1023);
#pragma unroll
                for (int r = 0; r < 4; ++r) s4[r] = s4[r] * 0.125f + bt_g[r * 1024 + dist];
            }
            float f[4];
#pragma unroll
            for (int r = 0; r < 4; ++r) {
                const float mb = wave_max(valid ? s4[r] : -1e30f);
                const float mn = fmaxf(m[r], mb);
                f[r] = expf(m[r] - mn);
                const float e = valid ? expf(s4[r] - mn) : 0.f;
                lsum[r] = lsum[r] * f[r] + wave_sum(e);
                m[r] = mn;
                pl[r * 64 + lane] = e;
                o[r] *= f[r];
            }
            WAVE_SYNC();
            const int klo = max(0, -p0), khi = min(63, t - p0);
            for (int k = klo; k <= khi; ++k) {
                const float v = bf2f(Z[(size_t)(b * SEQ + p0 + k) * ZLD + vcol + lane]);
                o[0] += pl[k] * v; o[1] += pl[64 + k] * v; o[2] += pl[128 + k] * v; o[3] += pl[192 + k] * v;
            }
            WAVE_SYNC();
        }
#pragma unroll
        for (int r = 0; r < 4; ++r) obr[br][r] = o[r] / fmaxf(lsum[r], 1e-30f);
    }
#pragma unroll
    for (int r = 0; r < 4; ++r) {
        const bf16_t* gp = zrow + ZC_NG + g * 12 + r * 3;
        const float g0 = sigmoidf_(bf2f(gp[0])), g1 = sigmoidf_(bf2f(gp[1])), g2 = sigmoidf_(bf2f(gp[2]));
        Y[(size_t)bt * DM + 512 + g * 256 + r * 64 + lane] = f2bf(g0 * ocmp[r] + g1 * obr[0][r] + g2 * obr[1][r]);
    }
    WAVE_SYNC();
}

__device__ __forceinline__ void final_norm(float* X, const float* ssq, const float* gain, int bid, int nb) {
    const int wave = tidx() >> 6, lane = tidx() & 63;
    for (int r = bid * NWAVE + wave; r < MTOK; r += nb * NWAVE) {
        const float rs = rstd_of(ssq, r);
#pragma unroll
        for (int j = 0; j < 4; ++j) {
            f32x4* px = (f32x4*)(X + (size_t)r * DM + j * 256 + lane * 4);
            const f32x4 gv = *(const f32x4*)(gain + j * 256 + lane * 4);
            f32x4 v = *px; v.x *= rs * gv.x; v.y *= rs * gv.y; v.z *= rs * gv.z; v.w *= rs * gv.w; *px = v;
        }
    }
}

namespace hg {
typedef short bf16x8 __attribute__((ext_vector_type(8)));
typedef unsigned u32x4 __attribute__((ext_vector_type(4)));
constexpr int LDP = 72;
constexpr int OFF_KT = 0, OFF_VT = 9216, OFF_QH = 18432, OFF_QT = 27648, OFF_KV = 36864, OFF_AM = 59904, OFF_O = 69120, OFF_SEG = 86528, HG_LDS = 88576;
__device__ __forceinline__ unsigned pk2(float lo, float hi) { return pg8::cvt_pk_bf16(lo, hi); }
__device__ __forceinline__ bf16x8 ldsfrag(const unsigned char* base, int row, int col) { return *(const bf16x8*)(base + (row * LDP + col) * 2); }

__device__ __forceinline__ void prep(const bf16_t* Z, int item, float lbv, float (&bb)[8], float (&kk)[8], float (&qq)[8], float (&vv)[8],
                                     float& tot, float& r1, float& r2, float& r3, float* seg_lds) {
    const int d = tidx() & 63, seg = tidx() >> 6;
    const int bh = item >> 7, c = item & 127, b_ = bh >> 2, h = bh & 3;
    const bf16_t* zp = Z + (size_t)(b_ * SEQ + c * 64 + seg * 8) * ZLD + h * 64 + d;
    float run = 0.f;
#pragma unroll
    for (int j = 0; j < 8; ++j) {
        const float q = bf2f(zp[(size_t)j * ZLD + ZC_HQ]), fl = bf2f(zp[(size_t)j * ZLD + ZC_HF]), iv = bf2f(zp[(size_t)j * ZLD + ZC_HI]);
        const float e = __expf(-fabsf(fl)), inv = 1.f / (1.f + e);
        const float sig = fl >= 0.f ? inv : e * inv, sigm = fl >= 0.f ? e * inv : inv;
        const float f = lbv + (1.f - lbv) * sig;
        run += __logf(fmaxf(f, 1e-30f));
        bb[j] = run; kk[j] = (1.f - lbv) * sigm; qq[j] = q / (1.f + __expf(-q)); vv[j] = iv;
    }
    seg_lds[seg * 64 + d] = run;
    __syncthreads();
    float pre = 0.f, off = 0.f; r1 = 0.f; r2 = 0.f; r3 = 0.f;
#pragma unroll
    for (int i = 0; i < 8; ++i) {
        if (i == 2) r1 = pre; if (i == 4) r2 = pre; if (i == 6) r3 = pre;
        if (i == seg) off = pre;
        pre += seg_lds[i * 64 + d];
    }
    tot = pre;
#pragma unroll
    for (int j = 0; j < 8; ++j) bb[j] += off;
}

__device__ __forceinline__ void phase1(const bf16_t* Z, const float* LBl, float* DS, float* GAM, unsigned char* lds, int item) {
    const int tid = tidx(), lane = tid & 63, wave = tid >> 6, d = lane, seg = wave;
    const int h = (item >> 7) & 3;
    float bb[8], kk[8], qq[8], vv[8], tot, r1, r2, r3;
    prep(Z, item, LBl[h * 64 + d], bb, kk, qq, vv, tot, r1, r2, r3, (float*)(lds + OFF_SEG));
    {
        float kh[8];
#pragma unroll
        for (int j = 0; j < 8; ++j) kh[j] = kk[j] * __expf(tot - bb[j]);
        u32x4 w; w.x = pk2(kh[0], kh[1]); w.y = pk2(kh[2], kh[3]); w.z = pk2(kh[4], kh[5]); w.w = pk2(kh[6], kh[7]);
        *(u32x4*)(lds + OFF_KT + (d * LDP + 8 * seg) * 2) = w;
        u32x4 v; v.x = pk2(vv[0], vv[1]); v.y = pk2(vv[2], vv[3]); v.z = pk2(vv[4], vv[5]); v.w = pk2(vv[6], vv[7]);
        *(u32x4*)(lds + OFF_VT + (d * LDP + 8 * seg) * 2) = v;
        if (seg == 0) GAM[(size_t)item * 64 + d] = __expf(tot);
    }
    __syncthreads();
    const int row = lane & 15, kq = lane >> 4, mt = wave >> 1;
#pragma unroll
    for (int q = 0; q < 2; ++q) {
        const int nt = (wave & 1) * 2 + q;
        f32x4 acc = (f32x4){0.f, 0.f, 0.f, 0.f};
#pragma unroll
        for (int ks = 0; ks < 2; ++ks) {
            const bf16x8 a = ldsfrag(lds + OFF_VT, 16 * mt + row, 32 * ks + 8 * kq);
            const bf16x8 bq = ldsfrag(lds + OFF_KT, 16 * nt + row, 32 * ks + 8 * kq);
            acc = __builtin_amdgcn_mfma_f32_16x16x32_bf16(a, bq, acc, 0, 0, 0);
        }
        float* o = DS + (size_t)item * 4096 + (16 * mt + 4 * kq) * 64 + 16 * nt + row;
#pragma unroll
        for (int r = 0; r < 4; ++r) o[r * 64] = acc[r];
    }
    __syncthreads();
}

__device__ __forceinline__ void phase2(const float* DS, const float* GAM, bf16_t* ST, int idx  ) {
    const int bh = idx >> 12, ed = idx & 4095, d = ed & 63;
    float S = 0.f;
    for (int c0 = 0; c0 < 128; c0 += 32) {
        float ds[32], gm[32];
#pragma unroll
        for (int j = 0; j < 32; ++j) { ds[j] = DS[(size_t)(bh * 128 + c0 + j) * 4096 + ed]; gm[j] = GAM[(size_t)(bh * 128 + c0 + j) * 64 + d]; }
#pragma unroll
        for (int j = 0; j < 32; ++j) { ST[(size_t)(bh * 128 + c0 + j) * 4096 + ed] = f2bf(S); S = gm[j] * S + ds[j]; }
    }
}

__device__ __forceinline__ void phase3(const bf16_t* Z, const float* LBl, const float* gain, const bf16_t* ST, bf16_t* Y, unsigned char* lds, int item) {
    const int tid = tidx(), lane = tid & 63, wave = tid >> 6, d = lane, seg = wave;
    const int bh = item >> 7, c = item & 127, b_ = bh >> 2, h = bh & 3;
    float bb[8], kk[8], qq[8], vv[8], tot, r1, r2, r3;
    prep(Z, item, LBl[h * 64 + d], bb, kk, qq, vv, tot, r1, r2, r3, (float*)(lds + OFF_SEG));
    {
        u32x4 v; v.x = pk2(vv[0], vv[1]); v.y = pk2(vv[2], vv[3]); v.z = pk2(vv[4], vv[5]); v.w = pk2(vv[6], vv[7]);
        *(u32x4*)(lds + OFF_VT + (d * LDP + 8 * seg) * 2) = v;
        const int it = seg >> 1;
        const float rr[4] = {0.f, r1, r2, r3};
        const float rmine = it == 0 ? 0.f : (it == 1 ? r1 : (it == 2 ? r2 : r3));
        bf16_t* QH = (bf16_t*)(lds + OFF_QH); bf16_t* QT = (bf16_t*)(lds + OFF_QT); bf16_t* KV = (bf16_t*)(lds + OFF_KV);
#pragma unroll
        for (int j = 0; j < 8; ++j) {
            const int t = 8 * seg + j;
            QH[t * LDP + d] = f2bf(qq[j] * __expf(bb[j]));
            QT[t * LDP + d] = f2bf(qq[j] * __expf(bb[j] - rmine));
#pragma unroll
            for (int i = 0; i < 4; ++i) {
                const int base = (i == 0) ? 0 : (i == 1 ? 16 : (i == 2 ? 48 : 96));
                if (i >= it) KV[(base + t) * LDP + d] = f2bf(kk[j] * __expf(rr[i] - bb[j]));
            }
        }
        bf16_t* AM = (bf16_t*)(lds + OFF_AM);
        { const int blk = tid >> 8, e = tid & 255, r = e >> 4, cc = e & 15; AM[(32 * blk + r) * LDP + 16 + 32 * blk + cc] = 0; }
    }
    __syncthreads();
    const int row = lane & 15, kq = lane >> 4;
    {
        bf16_t* AM = (bf16_t*)(lds + OFF_AM);
#pragma unroll
        for (int rep = 0; rep < 2; ++rep) {
            const int blk = wave + 8 * rep;
            if (blk < 10) {
                const int i = blk == 0 ? 0 : (blk < 3 ? 1 : (blk < 6 ? 2 : 3));
                const int j = blk - (i == 0 ? 0 : (i == 1 ? 1 : (i == 2 ? 3 : 6)));
                const int base = (i == 0) ? 0 : (i == 1 ? 16 : (i == 2 ? 48 : 96));
                f32x4 acc = (f32x4){0.f, 0.f, 0.f, 0.f};
#pragma unroll
                for (int ks = 0; ks < 2; ++ks) {
                    const bf16x8 a = ldsfrag(lds + OFF_QT, 16 * i + row, 32 * ks + 8 * kq);
                    const bf16x8 bq = ldsfrag(lds + OFF_KV, base + 16 * j + row, 32 * ks + 8 * kq);
                    acc = __builtin_amdgcn_mfma_f32_16x16x32_bf16(a, bq, acc, 0, 0, 0);
                }
#pragma unroll
                for (int r = 0; r < 4; ++r) {
                    const int tl = 4 * kq + r, sl = row;
                    const float v = (i == j && sl > tl) ? 0.f : acc[r];
                    AM[(16 * i + tl) * LDP + 16 * j + sl] = f2bf(v);
                }
            }
        }
    }
    __syncthreads();
    {
        const int mt = wave >> 1;
        float* O = (float*)(lds + OFF_O);
        const bf16_t* Sg = ST + (size_t)item * 4096;
#pragma unroll
        for (int q = 0; q < 2; ++q) {
            const int nt = (wave & 1) * 2 + q;
            f32x4 acc = (f32x4){0.f, 0.f, 0.f, 0.f};
#pragma unroll
            for (int ks = 0; ks < 2; ++ks) {
                if (ks <= (mt >> 1)) {
                    const bf16x8 a = ldsfrag(lds + OFF_AM, 16 * mt + row, 32 * ks + 8 * kq);
                    const bf16x8 bq = ldsfrag(lds + OFF_VT, 16 * nt + row, 32 * ks + 8 * kq);
                    acc = __builtin_amdgcn_mfma_f32_16x16x32_bf16(a, bq, acc, 0, 0, 0);
                }
            }
#pragma unroll
            for (int ks = 0; ks < 2; ++ks) {
                const bf16x8 a = ldsfrag(lds + OFF_QH, 16 * mt + row, 32 * ks + 8 * kq);
                const bf16x8 bq = *(const bf16x8*)(Sg + (16 * nt + row) * 64 + 32 * ks + 8 * kq);
                acc = __builtin_amdgcn_mfma_f32_16x16x32_bf16(a, bq, acc, 0, 0, 0);
            }
#pragma unroll
            for (int r = 0; r < 4; ++r) O[(16 * mt + 4 * kq + r) * 68 + 16 * nt + row] = acc[r];
        }
    }
    __syncthreads();
    {
        const int t = tid >> 3, e0 = (tid & 7) * 8;
        const float* O = (const float*)(lds + OFF_O) + t * 68 + e0;
        const f32x4 o0 = *(const f32x4*)O, o1 = *(const f32x4*)(O + 4);
        float ss = ((o0[0] * o0[0] + o0[1] * o0[1]) + (o0[2] * o0[2] + o0[3] * o0[3])) + ((o1[0] * o1[0] + o1[1] * o1[1]) + (o1[2] * o1[2] + o1[3] * o1[3]));
        ss += __shfl_xor(ss, 1); ss += __shfl_xor(ss, 2); ss += __shfl_xor(ss, 4);
        const float rs = rsqrtf(ss * (1.f / 64.f) + EPS);
        const size_t tok = (size_t)(b_ * SEQ + c * 64 + t);
        const u32x4 gw = *(const u32x4*)(Z + tok * ZLD + ZC_HG + h * 64 + e0);
        const f32x4 g0 = *(const f32x4*)(gain + e0), g1 = *(const f32x4*)(gain + e0 + 4);
        float ov[8] = {o0[0], o0[1], o0[2], o0[3], o1[0], o1[1], o1[2], o1[3]};
        const float gn[8] = {g0[0], g0[1], g0[2], g0[3], g1[0], g1[1], g1[2], g1[3]};
        const unsigned gwv[4] = {gw.x, gw.y, gw.z, gw.w};
#pragma unroll
        for (int j = 0; j < 8; ++j) {
            const float gv = __uint_as_float((j & 1) ? (gwv[j >> 1] & 0xffff0000u) : (gwv[j >> 1] << 16));
            ov[j] = ov[j] * rs * gn[j] * (gv / (1.f + __expf(-gv)));
        }
        u32x4 w; w.x = pk2(ov[0], ov[1]); w.y = pk2(ov[2], ov[3]); w.z = pk2(ov[4], ov[5]); w.w = pk2(ov[6], ov[7]);
        *(u32x4*)(Y + tok * DM + 256 + h * 64 + e0) = w;
    }
    __syncthreads();
}
}

namespace s5 {
typedef short bf16x8 __attribute__((ext_vector_type(8)));
typedef unsigned u32x4 __attribute__((ext_vector_type(4)));
typedef unsigned u32x2 __attribute__((ext_vector_type(2)));
constexpr size_t T_KT = 0, T_A1 = 532480, T_A2 = T_A1 + 4194304, T_LAYER = T_A2 + 4194304;
constexpr int UPITCH = 2064;
constexpr int OFF_U = 0, OFF_KT = 16 * UPITCH  , S5_LDS = OFF_KT + 65 * 512;

__device__ __forceinline__ void pow_table(const Params& p, float* POW, int gtid, int gthreads) {
    for (int i = gtid; i < 2 * 16 * 65 * 64; i += gthreads) {
        const int pp = i & 63, j = (i >> 6) % 65, lg = i / (65 * 64), g = lg & 15, l = lg >> 4, gp = g * 64 + pp;
        const double lr = (double)p.in[8][l * 1024 + gp], li = (double)p.in[9][l * 1024 + gp], dt = exp((double)p.in[10][l * 16 + g]);
        const double mag = exp(lr * dt * (double)j), ang = li * dt * (double)j;
        POW[2 * (size_t)i] = (float)(mag * cos(ang)); POW[2 * (size_t)i + 1] = (float)(mag * sin(ang));
    }
}
__device__ __forceinline__ void build_tables(const Params& p, int l, const float* POW, const float* tab, unsigned char* T, int gtid, int gthreads) {
    const float2* powl = (const float2*)POW + (size_t)l * 16 * 65 * 64;
    const float* bbr = tab + 2048; const float* bbi = tab + 2048 + 16384;
    const float* c_re = p.in[13] + l * 16384; const float* c_im = p.in[14] + l * 16384;
    bf16_t* KT = (bf16_t*)(T + T_KT); bf16_t* A1 = (bf16_t*)(T + T_A1); bf16_t* A2 = (bf16_t*)(T + T_A2);
    for (int i = gtid; i < 16 * 65 * 256; i += gthreads) {
        const int hi = i & 15, ho = (i >> 4) & 15, li = (i >> 8) % 65, g = i / (65 * 256);
        float acc = 0.f;
        if (li > 0) {
            const float2* pw = powl + (size_t)(g * 65 + li - 1) * 64;
            const float* cr = c_re + (g * 16 + ho) * 64; const float* ci = c_im + (g * 16 + ho) * 64;
#pragma unroll 8
            for (int pp = 0; pp < 64; ++pp) {
                const float2 pq = pw[pp];
                const float br = bbr[(g * 64 + pp) * 16 + hi], bi = bbi[(g * 64 + pp) * 16 + hi];
                acc += cr[pp] * (pq.x * br - pq.y * bi) - ci[pp] * (pq.x * bi + pq.y * br);
            }
        }
        KT[i] = f2bf(acc);
    }
    for (int i = gtid; i < 16 * 64 * 64 * 8; i += gthreads) {
        const int hp = i & 7, s = (i >> 3) & 63, pp = (i >> 9) & 63, g = i >> 15, gp = g * 64 + pp;
        const float2 pq = powl[(size_t)(g * 65 + 63 - s) * 64 + pp];
        const float br0 = bbr[gp * 16 + 2 * hp], bi0 = bbi[gp * 16 + 2 * hp], br1 = bbr[gp * 16 + 2 * hp + 1], bi1 = bbi[gp * 16 + 2 * hp + 1];
        unsigned* o0 = (unsigned*)(A1 + ((size_t)(g * 128 + 2 * pp) * 1024 + s * 16 + 2 * hp));
        o0[0] = pg8::cvt_pk_bf16(pq.x * br0 - pq.y * bi0, pq.x * br1 - pq.y * bi1);
        o0[512] = pg8::cvt_pk_bf16(pq.x * bi0 + pq.y * br0, pq.x * bi1 + pq.y * br1);
    }
    for (int i = gtid; i < 16 * 64 * 16 * 64; i += gthreads) {
        const int pp = i & 63, ho = (i >> 6) & 15, t = (i >> 10) & 63, g = i >> 16;
        const float2 pq = powl[(size_t)(g * 65 + t + 1) * 64 + pp];
        const float cr = c_re[(g * 16 + ho) * 64 + pp], ci = c_im[(g * 16 + ho) * 64 + pp];
        *(unsigned*)(A2 + ((size_t)(g * 1024 + t * 16 + ho) * 128 + 2 * pp)) = pg8::cvt_pk_bf16(cr * pq.x - ci * pq.y, -(cr * pq.y + ci * pq.x));
    }
}
__device__ __forceinline__ void stage_u(const bf16_t* Z, int g, int b_, int cgrp, unsigned char* lds) {
#pragma unroll
    for (int q = 0; q < 4; ++q) {
        const int i = tidx() + 512 * q, n = i >> 7, s = (i >> 1) & 63, half = i & 1;
        const u32x4 v = *(const u32x4*)(Z + (size_t)(b_ * SEQ + (cgrp * 16 + n) * 64 + s) * ZLD + ZC_U + g * 16 + 8 * half);
        *(u32x4*)(lds + OFF_U + n * UPITCH + s * 32 + half * 16) = v;
    }
}
__device__ __forceinline__ bf16x8 ufrag(const unsigned char* lds, int n, int ks, int kq) { return *(const bf16x8*)(lds + OFF_U + n * UPITCH + (2 * ks + (kq >> 1)) * 32 + (kq & 1) * 16); }

__device__ __forceinline__ void phase1(const bf16_t* Z, const unsigned char* T, float* XE, unsigned char* lds, int item) {
    const int lane = tidx() & 63, wave = tidx() >> 6, row = lane & 15, kq = lane >> 4;
    const int g = item >> 4, b_ = (item >> 3) & 1, cgrp = item & 7;
    stage_u(Z, g, b_, cgrp, lds);
    __syncthreads();
    const bf16_t* A1 = (const bf16_t*)(T + T_A1) + (size_t)(g * 128 + 16 * wave + row) * 1024 + 8 * kq;
    f32x4 acc = (f32x4){0.f, 0.f, 0.f, 0.f};
#pragma unroll 8
    for (int ks = 0; ks < 32; ++ks) {
        const bf16x8 a = *(const bf16x8*)(A1 + 32 * ks);
        acc = __builtin_amdgcn_mfma_f32_16x16x32_bf16(a, ufrag(lds, row, ks, kq), acc, 0, 0, 0);
    }
    *(f32x4*)(XE + ((size_t)((b_ * 16 + g) * 128 + cgrp * 16 + row)) * 128 + 16 * wave + 4 * kq) = acc;
    __syncthreads();
}
__device__ __forceinline__ void phase2(const float* XE, const float* A64l  , bf16_t* XC, int idx  ) {
    const int bg = idx >> 6, pp = idx & 63, g = bg & 15;
    const float ar = A64l[(g * 64 + pp) * 2], ai = A64l[(g * 64 + pp) * 2 + 1];
    float xr = 0.f, xi = 0.f;
    for (int c0 = 0; c0 < 128; c0 += 16) {
        float er[16], ei[16];
#pragma unroll
        for (int j = 0; j < 16; ++j) { const float2 e = *(const float2*)(XE + ((size_t)(bg * 128 + c0 + j)) * 128 + 2 * pp); er[j] = e.x; ei[j] = e.y; }
#pragma unroll
        for (int j = 0; j < 16; ++j) {
            *(unsigned*)(XC + ((size_t)(bg * 128 + c0 + j)) * 128 + 2 * pp) = pg8::cvt_pk_bf16(xr, xi);
            const float nr = ar * xr - ai * xi + er[j], ni = ar * xi + ai * xr + ei[j];
            xr = nr; xi = ni;
        }
    }
}
__device__ __forceinline__ void phase3(const Params& p, int l, const bf16_t* Z, const unsigned char* T, const bf16_t* XC, bf16_t* Y, unsigned char* lds, int item) {
    const int tid = tidx(), lane = tid & 63, wave = tid >> 6, row = lane & 15, kq = lane >> 4;
    const int g = item >> 4, b_ = (item >> 3) & 1, cgrp = item & 7;
    stage_u(Z, g, b_, cgrp, lds);
    {
        const u32x4* src = (const u32x4*)(T + T_KT + (size_t)g * 65 * 512);
        for (int i = tid; i < 65 * 32; i += NT) *(u32x4*)(lds + OFF_KT + i * 16) = src[i];
    }
    __syncthreads();
    const bf16_t* xcp = XC + ((size_t)((b_ * 16 + g) * 128 + cgrp * 16 + row)) * 128 + 8 * kq;
    bf16x8 xc[4];
#pragma unroll
    for (int ks = 0; ks < 4; ++ks) xc[ks] = *(const bf16x8*)(xcp + 32 * ks);
    const float* dsk = p.in[15] + l * 256 + g * 16 + 4 * kq;
    const f32x4 dv = *(const f32x4*)dsk;
    for (int q = 0; q < 8; ++q) {
        const int t = 8 * q + ((q & 1) ? (7 - wave) : wave);
        f32x4 acc = (f32x4){0.f, 0.f, 0.f, 0.f};
        const bf16_t* A2 = (const bf16_t*)(T + T_A2) + (size_t)(g * 1024 + t * 16 + row) * 128 + 8 * kq;
#pragma unroll
        for (int ks = 0; ks < 4; ++ks) acc = __builtin_amdgcn_mfma_f32_16x16x32_bf16(*(const bf16x8*)(A2 + 32 * ks), xc[ks], acc, 0, 0, 0);
        const int nks = (t >> 1) + 1;
        for (int ks = 0; ks < nks; ++ks) {
            const int s = 2 * ks + (kq >> 1), li = t - s + 1;
            const bf16x8 a = *(const bf16x8*)(lds + OFF_KT + ((li * 16 + row) * 16 + 8 * (kq & 1)) * 2);
            acc = __builtin_amdgcn_mfma_f32_16x16x32_bf16(a, ufrag(lds, row, ks, kq), acc, 0, 0, 0);
        }
        const size_t tok = (size_t)(b_ * SEQ + (cgrp * 16 + row) * 64 + t);
        const u32x2 uw = *(const u32x2*)(Z + tok * ZLD + ZC_U + g * 16 + 4 * kq);
        const float u0 = __uint_as_float(uw.x << 16), u1 = __uint_as_float(uw.x & 0xffff0000u), u2 = __uint_as_float(uw.y << 16), u3 = __uint_as_float(uw.y & 0xffff0000u);
        const float y0 = gelu_tanh(acc[0] + dv[0] * u0), y1 = gelu_tanh(acc[1] + dv[1] * u1), y2 = gelu_tanh(acc[2] + dv[2] * u2), y3 = gelu_tanh(acc[3] + dv[3] * u3);
        u32x2 w; w.x = pg8::cvt_pk_bf16(y0, y1); w.y = pg8::cvt_pk_bf16(y2, y3);
        *(u32x2*)(Y + tok * DM + g * 16 + 4 * kq) = w;
    }
    __syncthreads();
}
}
namespace pg8 {
struct EpiGLU {
    static constexpr bool PERM = true, AFTER_DRAIN = false;
    bf16_t* Y;
    __device__ __forceinline__ void operator()(const f32x4 (&acc)[2][2][4][2], const Unit& u, int wr, int wc, int fr, int fq) const {
#pragma unroll
        for (int ai = 0; ai < 2; ++ai)
#pragma unroll
            for (int m = 0; m < 4; ++m) {
                const int row = u.pm * BM + ai * HALF + wr * 64 + m * 16 + fr;
#pragma unroll
                for (int bj = 0; bj < 2; ++bj) {
                    const int col0 = u.pn * BM + bj * HALF + wc * 32 + 8 * fq;
                    u32x4* py = (u32x4*)(Y + (size_t)row * 1024 + col0);
                    const u32x4 yw = *py;
                    const unsigned ywv[4] = {yw.x, yw.y, yw.z, yw.w};
                    float o[8];
#pragma unroll
                    for (int j = 0; j < 8; ++j) {
                        const float yv = __uint_as_float((j & 1) ? (ywv[j >> 1] & 0xffff0000u) : (ywv[j >> 1] << 16));
                        const float a = acc[ai][bj][m][j >> 2][j & 3];
                        o[j] = yv * __builtin_amdgcn_rcpf(1.0f + __builtin_amdgcn_exp2f(-1.4426950408889634f * a));
                    }
                    u32x4 w; w.x = cvt_pk_bf16(o[0], o[1]); w.y = cvt_pk_bf16(o[2], o[3]); w.z = cvt_pk_bf16(o[4], o[5]); w.w = cvt_pk_bf16(o[6], o[7]);
                    *py = w;
                }
            }
    }
};
}

__device__ __forceinline__ void nsa_slc_naive(const bf16_t* Z, const unsigned* SELMASK, bf16_t* Y, const float* btab, float* lw, int item) {
    const int lane = tidx() & 63;
    const int g = item & 1, bt = item >> 1, b = bt / SEQ, t = bt % SEQ;
    float* qs = lw; float* pl = lw + 256;
    const bf16_t* zrow = Z + (size_t)bt * ZLD;
#pragma unroll
    for (int r = 0; r < 4; ++r) qs[r * 64 + lane] = bf2f(zrow[ZC_NQ + g * 256 + r * 64 + lane]);
    WAVE_SYNC();
    const float* bt_g = btab + (g * 4) * 1024;
    const unsigned* mk = SELMASK + ((size_t)(b * 2 + g) * SEQ + t) * 4;
    float m[4] = {-1e30f, -1e30f, -1e30f, -1e30f}, lsum[4] = {0.f, 0.f, 0.f, 0.f}, o[4] = {0.f, 0.f, 0.f, 0.f};
    const int kcol = ZC_NKV + 2 * 128 + g * 64, vcol = kcol + 128;
    for (int jb = 0; jb * 64 <= t; ++jb) {
        if (!((mk[jb >> 5] >> (jb & 31)) & 1u)) continue;
        const int p0 = jb * 64, pos = p0 + lane;
        const bool valid = pos <= t;
        float s4[4] = {0.f, 0.f, 0.f, 0.f};
        if (valid) {
            const bf16_t* kr = Z + (size_t)(b * SEQ + pos) * ZLD + kcol;
            for (int d = 0; d < 64; d += 4) {
                const ushort4 k4 = *(const ushort4*)(kr + d);
                const float k0 = bf2f(k4.x), k1 = bf2f(k4.y), k2 = bf2f(k4.z), k3 = bf2f(k4.w);
#pragma unroll
                for (int r = 0; r < 4; ++r) s4[r] += qs[r * 64 + d] * k0 + qs[r * 64 + d + 1] * k1 + qs[r * 64 + d + 2] * k2 + qs[r * 64 + d + 3] * k3;
            }
            const int dist = min(t - pos, 1023);
#pragma unroll
            for (int r = 0; r < 4; ++r) s4[r] = s4[r] * 0.125f + bt_g[r * 1024 + dist];
        }
#pragma unroll
        for (int r = 0; r < 4; ++r) {
            const float mb = wave_max(valid ? s4[r] : -1e30f);
            const float mn = fmaxf(m[r], mb);
            const float f = expf(m[r] - mn);
            const float e = valid ? expf(s4[r] - mn) : 0.f;
            lsum[r] = lsum[r] * f + wave_sum(e);
            m[r] = mn; pl[r * 64 + lane] = e; o[r] *= f;
        }
        WAVE_SYNC();
        const int khi = min(63, t - p0);
        for (int k = 0; k <= khi; ++k) {
            const float v = bf2f(Z[(size_t)(b * SEQ + p0 + k) * ZLD + vcol + lane]);
            o[0] += pl[k] * v; o[1] += pl[64 + k] * v; o[2] += pl[128 + k] * v; o[3] += pl[192 + k] * v;
        }
        WAVE_SYNC();
    }
#pragma unroll
    for (int r = 0; r < 4; ++r) {
        const float g1 = sigmoidf_(bf2f(zrow[ZC_NG + g * 12 + r * 3 + 1]));
        bf16_t* yp = Y + (size_t)bt * DM + 512 + g * 256 + r * 64 + lane;
        *yp = f2bf(bf2f(*yp) + g1 * o[r] / fmaxf(lsum[r], 1e-30f));
    }
    WAVE_SYNC();
}
namespace nsa {
typedef short bf16x8 __attribute__((ext_vector_type(8)));
typedef short s16x4 __attribute__((ext_vector_type(4)));
typedef float f32x16 __attribute__((ext_vector_type(16)));
typedef unsigned u32x4 __attribute__((ext_vector_type(4)));
#define NSA_LAS __attribute__((address_space(3)))
constexpr int KP = 72;
constexpr float LOG2E = 1.4426950408889634f, QSCALE = 0.125f * LOG2E, THR = 8.0f;
constexpr int TILE_B = 64 * KP * 2;
constexpr int BTP = 1040;
constexpr int OFF_BT = 0, OFF_K = 8 * BTP * 4, OFF_V = OFF_K + 2 * TILE_B, OFF_WS = OFF_V + 2 * TILE_B, WS_PER_WAVE = 256 + 8192, NSA_LDS = OFF_WS + 8 * WS_PER_WAVE;
static_assert(NSA_LDS <= LDS_BYTES, "nsa lds");
__device__ __forceinline__ int crow(int i, int h) { return (i & 3) + 8 * (i >> 2) + 4 * h; }
__device__ __forceinline__ float dpp_xor1(float v) { return __int_as_float(__builtin_amdgcn_update_dpp(0, __float_as_int(v), 0xB1, 0xF, 0xF, true)); }
__device__ __forceinline__ float dpp_xor2(float v) { return __int_as_float(__builtin_amdgcn_update_dpp(0, __float_as_int(v), 0x4E, 0xF, 0xF, true)); }
#define NSA_LWAIT() asm volatile("s_waitcnt lgkmcnt(0)" ::: "memory")
__device__ __forceinline__ float dpp_hmir(float v) { return __int_as_float(__builtin_amdgcn_update_dpp(0, __float_as_int(v), 0x141, 0xF, 0xF, true)); }
__device__ __forceinline__ int dppi_xor1(int v) { return __builtin_amdgcn_update_dpp(0, v, 0xB1, 0xF, 0xF, true); }
__device__ __forceinline__ int dppi_xor2(int v) { return __builtin_amdgcn_update_dpp(0, v, 0x4E, 0xF, 0xF, true); }
__device__ __forceinline__ int dppi_hmir(int v) { return __builtin_amdgcn_update_dpp(0, v, 0x141, 0xF, 0xF, true); }
__device__ __forceinline__ float swapadd(float v) {
    auto rr = __builtin_amdgcn_permlane32_swap(__float_as_uint(v), __float_as_uint(v), false, false);
    return __uint_as_float(rr[0]) + __uint_as_float(rr[1]);
}

__device__ __forceinline__ void fill_btab(const float* rel_bias, unsigned char* lds) {
    float* bt = (float*)(lds + OFF_BT);
    for (int i = tidx(); i < 8192; i += NT) { const int hh = i >> 10, d = i & 1023; bt[hh * BTP + d] = rel_bias[t5_bucket(d) * 8 + hh] * LOG2E; }
}
struct TileRegs { u32x4 k, v; };
__device__ __forceinline__ void tile_load(TileRegs& r, const bf16_t* kb, const bf16_t* vb, unsigned pitch, int r0) {
    const unsigned off = (unsigned)(r0 + (tidx() >> 3)) * pitch + (tidx() & 7) * 8;
    r.k = *(const u32x4*)(kb + off); r.v = *(const u32x4*)(vb + off);
}
__device__ __forceinline__ void tile_store(unsigned char* lds, int buf, const TileRegs& r) {
    const int o = ((tidx() >> 3) * KP + (tidx() & 7) * 8) * 2;
    *(u32x4*)(lds + OFF_K + buf * TILE_B + o) = r.k; *(u32x4*)(lds + OFF_V + buf * TILE_B + o) = r.v;
}
typedef NSA_LAS const unsigned char* ldsp;
__device__ __forceinline__ f32x16 qk32(ldsp Kl, const bf16x8 (&qf)[4], f32x16 c, int r32, int h) {
#pragma unroll
    for (int ks = 0; ks < 4; ++ks) {
        const bf16x8 kf = *(NSA_LAS const bf16x8*)(Kl + 32 * ks);
        c = __builtin_amdgcn_mfma_f32_32x32x16_bf16(kf, qf[ks], c, 0, 0, 0);
    }
    return c;
}
__device__ __forceinline__ s16x4 trread(ldsp p) { return __builtin_bit_cast(s16x4, __builtin_amdgcn_ds_read_tr16_b64_v4i16((NSA_LAS s16x4*)p)); }
__device__ __forceinline__ void pv32(f32x16 (&o)[2], ldsp Vl, const bf16x8 (&pf)[2], int lane) {
#pragma unroll
    for (int dt = 0; dt < 2; ++dt)
#pragma unroll
        for (int s = 0; s < 2; ++s) {
            ldsp a0 = Vl + (16 * s * KP + 32 * dt) * 2;
            const s16x4 lo = trread(a0), hi = trread(a0 + 8 * KP * 2);
            const bf16x8 vf = (bf16x8){lo[0], lo[1], lo[2], lo[3], hi[0], hi[1], hi[2], hi[3]};
            o[dt] = __builtin_amdgcn_mfma_f32_32x32x16_bf16(pf[s], vf, o[dt], 0, 0, 0);
        }
}
__device__ __forceinline__ void pack_p(const f32x16& s, bf16x8 (&pf)[2]) {
#pragma unroll
    for (int k = 0; k < 2; ++k) {
        u32x4 w; w.x = pg8::cvt_pk_bf16(s[8 * k + 0], s[8 * k + 1]); w.y = pg8::cvt_pk_bf16(s[8 * k + 2], s[8 * k + 3]); w.z = pg8::cvt_pk_bf16(s[8 * k + 4], s[8 * k + 5]); w.w = pg8::cvt_pk_bf16(s[8 * k + 6], s[8 * k + 7]);
        pf[k] = __builtin_bit_cast(bf16x8, w);
    }
}

__device__ __forceinline__ float swapmax(float v) {
    auto rr = __builtin_amdgcn_permlane32_swap(__float_as_uint(v), __float_as_uint(v), false, false);
    return fmaxf(__uint_as_float(rr[0]), __uint_as_float(rr[1]));
}
__device__ __forceinline__ float max16(const f32x16& s) {
    float a = __builtin_fmaxf(__builtin_fmaxf(s[0], s[1]), s[2]), b = __builtin_fmaxf(__builtin_fmaxf(s[3], s[4]), s[5]);
    a = __builtin_fmaxf(__builtin_fmaxf(a, s[6]), s[7]); b = __builtin_fmaxf(__builtin_fmaxf(b, s[8]), s[9]);
    a = __builtin_fmaxf(__builtin_fmaxf(a, s[10]), s[11]); b = __builtin_fmaxf(__builtin_fmaxf(b, s[12]), s[13]);
    a = __builtin_fmaxf(__builtin_fmaxf(a, s[14]), s[15]);
    return __builtin_fmaxf(a, b);
}
__device__ __forceinline__ void scale_rows(f32x16 (&o)[2], float f, float* wsf, int lane) {
    const int r32 = lane & 31, h = lane >> 5;
    if (h == 0) wsf[r32] = f;
    NSA_LWAIT();
#pragma unroll
    for (int i = 0; i < 16; ++i) { const float fi = wsf[crow(i, h)]; o[0][i] *= fi; o[1][i] *= fi; }
    NSA_LWAIT();
}
template <bool MASKED>
__device__ __forceinline__ void softmax_pv(f32x16 (&o)[2], float& m, float& lsum, f32x16& s, ldsp Vt, float* wsf, int lane) {
    float tmax = s[0];
#pragma unroll
    for (int i = 1; i < 16; ++i) tmax = fmaxf(tmax, s[i]);
    tmax = swapmax(tmax);
    if (__any(tmax > m + THR)) {
        const float mn = fmaxf(m, tmax), f = __builtin_amdgcn_exp2f(m - mn);
        lsum *= f; m = mn;
        scale_rows(o, f, wsf, lane);
    }
    float ps = 0.f;
#pragma unroll
    for (int i = 0; i < 16; ++i) { float pv = __builtin_amdgcn_exp2f(s[i] - m); if (MASKED) pv = s[i] > -1e29f ? pv : 0.f; s[i] = pv; ps += pv; }
    lsum += ps;
    bf16x8 pf[2]; pack_p(s, pf);
    pv32(o, Vt, pf, lane);
}

template <bool SEL>
__device__ __forceinline__ void softmax_pv2(f32x16 (&o)[2], float& m, float& lsum, f32x16& s0, f32x16& s1, ldsp Vt, float* wsf, int lane, bool lanesel) {
    float tmax = fmaxf(max16(s0), max16(s1));
    if (SEL) tmax = lanesel ? tmax : -1e30f;
    tmax = swapmax(tmax);
    if (__any(tmax > m + THR)) {
        const float mn = fmaxf(m, tmax), f = __builtin_amdgcn_exp2f(m - mn);
        lsum *= f; m = mn;
        scale_rows(o, f, wsf, lane);
    }
    const float mm = SEL ? (lanesel ? m : 1e30f) : m;
    float ps0 = 0.f, ps1 = 0.f;
#pragma unroll
    for (int i = 0; i < 16; ++i) { s0[i] = __builtin_amdgcn_exp2f(s0[i] - mm); ps0 += s0[i]; }
#pragma unroll
    for (int i = 0; i < 16; ++i) { s1[i] = __builtin_amdgcn_exp2f(s1[i] - mm); ps1 += s1[i]; }
    lsum += ps0 + ps1;
    bf16x8 pf0[2], pf1[2]; pack_p(s0, pf0); pack_p(s1, pf1);
    pv32(o, Vt, pf0, lane);
    pv32(o, Vt + 32 * KP * 2, pf1, lane);
}
__device__ __forceinline__ void load_q(bf16x8 (&qf)[4], const bf16_t* qp  ) {
#pragma unroll
    for (int ks = 0; ks < 4; ++ks) {
        const u32x4 w = *(const u32x4*)(qp + 16 * ks);
        const unsigned wv[4] = {w.x, w.y, w.z, w.w}; u32x4 o;
        unsigned ov[4];
#pragma unroll
        for (int j = 0; j < 4; ++j) ov[j] = pg8::cvt_pk_bf16(__uint_as_float(wv[j] << 16) * QSCALE, __uint_as_float(wv[j] & 0xffff0000u) * QSCALE);
        o.x = ov[0]; o.y = ov[1]; o.z = ov[2]; o.w = ov[3];
        qf[ks] = __builtin_bit_cast(bf16x8, o);
    }
}
__device__ __forceinline__ float gate_of(const bf16_t* zrow, int g, int hr, int br) { const float x = bf2f(zrow[ZC_NG + g * 12 + hr * 3 + br]); return 1.f / (1.f + __expf(-x)); }

__device__ __forceinline__ void softmax_rel(f32x16 (&o)[2], float& m, float& lsum, f32x16& s0, f32x16& s1, ldsp Vt, float* wsf, int lane) {
    const float tmax = swapmax(fmaxf(max16(s0), max16(s1)));
    if (__any(tmax > THR)) {
        const float d = fmaxf(tmax, 0.f), f = __builtin_amdgcn_exp2f(-d);
        m += d; lsum *= f;
        scale_rows(o, f, wsf, lane);
#pragma unroll
        for (int i = 0; i < 16; ++i) { s0[i] -= d; s1[i] -= d; }
    }
    float ps0 = 0.f, ps1 = 0.f;
#pragma unroll
    for (int i = 0; i < 16; ++i) { s0[i] = __builtin_amdgcn_exp2f(s0[i]); ps0 += s0[i]; }
#pragma unroll
    for (int i = 0; i < 16; ++i) { s1[i] = __builtin_amdgcn_exp2f(s1[i]); ps1 += s1[i]; }
    lsum += ps0 + ps1;
    bf16x8 pf0[2], pf1[2]; pack_p(s0, pf0); pack_p(s1, pf1);
    pv32(o, Vt, pf0, lane);
    pv32(o, Vt + 32 * KP * 2, pf1, lane);
}
__device__ __forceinline__ f32x16 splat16(float v) { return (f32x16){v, v, v, v, v, v, v, v, v, v, v, v, v, v, v, v}; }
__device__ __forceinline__ void softmax_rel1(f32x16 (&o)[2], float& m, float& lsum, f32x16& s0, ldsp Vt, float* wsf, int lane) {
    const float tmax = swapmax(max16(s0));
    if (__any(tmax > THR)) {
        const float d = fmaxf(tmax, 0.f), f = __builtin_amdgcn_exp2f(-d);
        m += d; lsum *= f;
        scale_rows(o, f, wsf, lane);
#pragma unroll
        for (int i = 0; i < 16; ++i) s0[i] -= d;
    }
    float ps0 = 0.f;
#pragma unroll
    for (int i = 0; i < 16; ++i) { s0[i] = __builtin_amdgcn_exp2f(s0[i]); ps0 += s0[i]; }
    lsum += ps0;
    bf16x8 pf0[2]; pack_p(s0, pf0);
    pv32(o, Vt, pf0, lane);
}
__device__ __forceinline__ void cmpwin_item(const bf16_t* Z, const bf16_t* KCb, const bf16_t* VCb, unsigned* SELMASK, bf16_t* Y, unsigned char* lds, int bg, int qt) {
    const int tid = tidx(), lane = tid & 63, wave = tid >> 6, r32 = lane & 31, h = lane >> 5;
    const int b_ = bg >> 1, g = bg & 1, tl = r32 >> 2, hr = r32 & 3;
    const int t = 64 * qt + 8 * wave + tl;
    const unsigned tok = (unsigned)(b_ * SEQ + t);
    const float* bt = (const float*)(lds + OFF_BT) + (g * 4 + hr) * BTP;
    float* wsf = (float*)(lds + OFF_WS + wave * WS_PER_WAVE);
    float* pmain = wsf + 64; float* pspill = pmain + 1024;
    const ldsp KL = (ldsp)lds + OFF_K + (r32 * KP + 8 * h) * 2;
    const ldsp VL = (ldsp)lds + OFF_V + ((4 * h + ((lane & 15) >> 2)) * KP + 16 * ((lane >> 4) & 1) + 4 * (lane & 3)) * 2;
    bf16x8 qf[4]; load_q(qf, Z + (tok * ZLD + ZC_NQ + g * 256 + hr * 64 + 8 * h));
    const f32x16 zero16 = (f32x16){0, 0, 0, 0, 0, 0, 0, 0, 0, 0, 0, 0, 0, 0, 0, 0};
    TileRegs tr;
    int buf = 0;
    const int cmax = min(4 * qt + 2, 510), nct = cmax / 64 + 1;
    const int cv = t >= 31 ? ((t - 31) >> 4) : -1;
    const bf16_t* kc = KCb + (unsigned)(bg * 512 * 64); const bf16_t* vc = VCb + (unsigned)(bg * 512 * 64);
    const bool dosel = qt >= 16;
    float m = -1e30f, l = 0.f;
    const float bfar = bt[1023];
    const int tmin = 64 * qt + 8 * wave;
    const int cvmin = tmin >= 31 ? ((tmin - 31) >> 4) : -1;
#define CMP_FAST(cbase) (((cbase) + 31 <= cvmin) && (tmin - 31 - 16 * ((cbase) + 31) >= 790))
    tile_load(tr, kc, vc, 64, 0);
    for (int j = 0; j < nct; ++j) {
        tile_store(lds, buf, tr); __syncthreads();
        if (j + 1 < nct) tile_load(tr, kc, vc, 64, 64 * (j + 1));
#pragma unroll
        for (int sub = 0; sub < 2; ++sub) {
            const int cbase = 64 * j + 32 * sub;
            if (cbase <= cmax) {
                const bool fast = CMP_FAST(cbase);
                f32x16 s = qk32(KL + buf * TILE_B + sub * 32 * KP * 2, qf, splat16(fast ? bfar : 0.f), r32, h);
                if (!fast) {
                    const int db = t - 31 - 16 * (cbase + 4 * h);
#pragma unroll
                    for (int i = 0; i < 16; ++i) {
                        const int co = (i & 3) + 8 * (i >> 2);
                        const float v = s[i] + bt[min((unsigned)(db - 16 * co), 1023u)];
                        s[i] = (cbase + 4 * h + co <= cv) ? v : -1e30f;
                    }
                }
                const float mn = fmaxf(m, swapmax(max16(s)));
                float ps = 0.f;
#pragma unroll
                for (int i = 0; i < 16; ++i) ps += __builtin_amdgcn_exp2f(s[i] - mn);
                l = (mn > -1e29f) ? l * __builtin_amdgcn_exp2f(m - mn) + ps : 0.f; m = mn;
            }
        }
        buf ^= 1;
    }
    l = swapadd(l);
    const float cb = (l > 0.f) ? -m - __builtin_amdgcn_logf(l) : 0.f;
    f32x16 oc[2] = {zero16, zero16};
    __syncthreads();
    tile_load(tr, kc, vc, 64, 0);
    for (int j = 0; j < nct; ++j) {
        tile_store(lds, buf, tr); __syncthreads();
        if (j + 1 < nct) tile_load(tr, kc, vc, 64, 64 * (j + 1));
#pragma unroll
        for (int sub = 0; sub < 2; ++sub) {
            const int cbase = 64 * j + 32 * sub;
            if (cbase <= cmax) {
                const bool fast = CMP_FAST(cbase);
                f32x16 s = qk32(KL + buf * TILE_B + sub * 32 * KP * 2, qf, splat16(fast ? bfar + cb : cb), r32, h);
                if (fast) {
#pragma unroll
                    for (int i = 0; i < 16; ++i) s[i] = __builtin_amdgcn_exp2f(s[i]);
                } else {
                    const int db = t - 31 - 16 * (cbase + 4 * h);
#pragma unroll
                    for (int i = 0; i < 16; ++i) {
                        const int co = (i & 3) + 8 * (i >> 2);
                        const float v = s[i] + bt[min((unsigned)(db - 16 * co), 1023u)];
                        s[i] = (cbase + 4 * h + co <= cv) ? __builtin_amdgcn_exp2f(v) : 0.f;
                    }
                }
                if (dosel) {
#pragma unroll
                    for (int q = 0; q < 4; ++q) {
                        float mainv = 2.f * (s[4 * q] + s[4 * q + 1] + s[4 * q + 2]) + s[4 * q + 3], spv = s[4 * q + 3];
                        mainv += dpp_xor1(mainv); mainv += dpp_xor2(mainv); spv += dpp_xor1(spv); spv += dpp_xor2(spv);
                        if (hr == 0) {
                            const int jb = (cbase >> 2) + 2 * q + h;
                            pmain[tl * 128 + jb] = mainv;
                            if (jb + 1 < 128) pspill[tl * 128 + jb + 1] = spv;
                        }
                    }
                }
                bf16x8 pf[2]; pack_p(s, pf);
                pv32(oc, VL + buf * TILE_B + sub * 32 * KP * 2, pf, lane);
            }
        }
        buf ^= 1;
    }
#undef CMP_FAST
    NSA_LWAIT();
    {
        const int stok = lane >> 3, si = lane & 7;
        unsigned mybits = 0u;
        if (dosel) {
            float vals[16];
#pragma unroll
            for (int k = 0; k < 16; ++k) { const int jb = si + 8 * k; vals[k] = (jb >= 1 && jb <= qt - 2) ? pmain[stok * 128 + jb] + pspill[stok * 128 + jb] : -1.f; }
            for (int it = 0; it < 13; ++it) {
                float bv = -2.f; int bk = 0;
#pragma unroll
                for (int k = 0; k < 16; ++k) if (vals[k] > bv) { bv = vals[k]; bk = k; }
                int bj = si + 8 * bk;
                { float ov = dpp_xor1(bv); int oj = dppi_xor1(bj); if (ov > bv || (ov == bv && oj < bj)) { bv = ov; bj = oj; }
                  ov = dpp_xor2(bv); oj = dppi_xor2(bj); if (ov > bv || (ov == bv && oj < bj)) { bv = ov; bj = oj; }
                  ov = dpp_hmir(bv); oj = dppi_hmir(bj); if (ov > bv || (ov == bv && oj < bj)) { bv = ov; bj = oj; } }
                const bool mine = (bj & 7) == si; const int wk = bj >> 3;
#pragma unroll
                for (int k = 0; k < 16; ++k) if (mine && k == wk) vals[k] = -3.f;
                if (mine) mybits |= 1u << wk;
            }
            if (si == 0) mybits |= 1u;
            if (((qt - 1) & 7) == si) mybits |= 1u << ((qt - 1) >> 3);
            if ((qt & 7) == si) mybits |= 1u << (qt >> 3);
        } else {
#pragma unroll
            for (int k = 0; k < 16; ++k) if (si + 8 * k <= qt) mybits |= 1u << k;
        }
        unsigned wd[4];
#pragma unroll
        for (int w = 0; w < 4; ++w) {
            unsigned x = 0u;
#pragma unroll
            for (int kk = 0; kk < 4; ++kk) if ((mybits >> (4 * w + kk)) & 1u) x |= 1u << (si + 8 * kk);
            x |= (unsigned)dppi_xor1((int)x); x |= (unsigned)dppi_xor2((int)x); x |= (unsigned)dppi_hmir((int)x);
            wd[w] = x;
        }
        if (si == 0) *(u32x4*)(SELMASK + (unsigned)((bg * SEQ + 64 * qt + 8 * wave + stok) * 4)) = (u32x4){wd[0], wd[1], wd[2], wd[3]};
    }
    { const int l2 = tidx() & 63, r2 = l2 & 31; const unsigned tk = (unsigned)(b_ * SEQ + 64 * qt + 8 * (tidx() >> 6) + (r2 >> 2)); scale_rows(oc, gate_of(Z + tk * ZLD, g, r2 & 3, 0), wsf, lane); }
    const unsigned yo = (unsigned)((b_ * SEQ + 64 * qt + 8 * wave + h) * DM + 512 + g * 256 + r32);
#pragma unroll
    for (int i = 0; i < 16; ++i) {
        const int ci = (i & 3) + 8 * (i >> 2);
        const unsigned o = yo + (unsigned)((ci >> 2) * DM + (ci & 3) * 64);
        Y[o] = f2bf(oc[0][i]); Y[o + 32] = f2bf(oc[1][i]);
    }
    f32x16 ow[2] = {zero16, zero16};
    m = 0.f; l = 0.f;
    const bf16_t* kw = Z + (unsigned)(b_ * SEQ * ZLD + ZC_NKV + 4 * 128 + g * 64); const bf16_t* vw = kw + 128;
    const int j0 = qt >= 8 ? qt - 8 : 0;
    __syncthreads();
    tile_load(tr, kw, vw, ZLD, 64 * j0);
    for (int j = j0; j <= qt; ++j) {
        tile_store(lds, buf, tr); __syncthreads();
        if (j < qt) tile_load(tr, kw, vw, ZLD, 64 * (j + 1));
        const bool edge = (j == qt) || (j == qt - 8);
        const f32x16 ci = splat16(-m);
        if (edge) {
#pragma unroll
            for (int sub = 0; sub < 2; ++sub) {
                const int kb = 64 * j + 32 * sub;
                if (kb > 64 * qt + 8 * wave + 7) continue;
                if (kb + 31 + 512 <= 64 * qt + 8 * wave) continue;
                f32x16 s = qk32(KL + buf * TILE_B + sub * 32 * KP * 2, qf, splat16(-m), r32, h);
                const int db = t - kb - 4 * h;
#pragma unroll
                for (int i = 0; i < 16; ++i) { const int dist = db - ((i & 3) + 8 * (i >> 2)); const float v = s[i] + bt[min((unsigned)dist, 1023u)]; s[i] = (dist >= 0 && dist < 512) ? v : -1e30f; }
                softmax_rel1(ow, m, l, s, VL + buf * TILE_B + sub * 32 * KP * 2, wsf, lane);
            }
        } else {
            f32x16 s0 = qk32(KL + buf * TILE_B, qf, ci, r32, h), s1 = qk32(KL + buf * TILE_B + 32 * KP * 2, qf, ci, r32, h);
            const int db = t - 64 * j - 4 * h;
#pragma unroll
            for (int i = 0; i < 16; ++i) { const int co = (i & 3) + 8 * (i >> 2); s0[i] += bt[db - co]; s1[i] += bt[db - 32 - co]; }
            softmax_rel(ow, m, l, s0, s1, VL + buf * TILE_B, wsf, lane);
        }
        buf ^= 1;
    }
    l = swapadd(l);
    { const int l2 = tidx() & 63, r2 = l2 & 31; const unsigned tk = (unsigned)(b_ * SEQ + 64 * qt + 8 * (tidx() >> 6) + (r2 >> 2)); scale_rows(ow, gate_of(Z + tk * ZLD, g, r2 & 3, 2) / fmaxf(l, 1e-30f), wsf, lane); }
#pragma unroll
    for (int i = 0; i < 16; ++i) {
        const int ci = (i & 3) + 8 * (i >> 2);
        const unsigned o = yo + (unsigned)((ci >> 2) * DM + (ci & 3) * 64);
        Y[o] = f2bf(bf2f(Y[o]) + ow[0][i]); Y[o + 32] = f2bf(bf2f(Y[o + 32]) + ow[1][i]);
    }
    __syncthreads();
}
constexpr int S2_TILE = 128 * KP * 2;
constexpr int S2_K = OFF_K, S2_V = S2_K + 2 * S2_TILE, S2_WS = S2_V + 2 * S2_TILE;
static_assert(S2_WS + 8 * 256 <= LDS_BYTES - 64, "slc lds");
struct TileRegs2 { u32x4 k0, k1, v0, v1; };
__device__ __forceinline__ void tile_load2(TileRegs2& r, const bf16_t* kb, const bf16_t* vb, int r0, int rmax) {
    const int ra = min(r0 + (tidx() >> 3), rmax), rb = min(r0 + 64 + (tidx() >> 3), rmax);
    const unsigned oa = (unsigned)ra * ZLD + (tidx() & 7) * 8, ob = (unsigned)rb * ZLD + (tidx() & 7) * 8;
    r.k0 = *(const u32x4*)(kb + oa); r.v0 = *(const u32x4*)(vb + oa); r.k1 = *(const u32x4*)(kb + ob); r.v1 = *(const u32x4*)(vb + ob);
}
__device__ __forceinline__ void tile_store2(unsigned char* lds, int buf, const TileRegs2& r) {
    const int o = ((tidx() >> 3) * KP + (tidx() & 7) * 8) * 2;
    *(u32x4*)(lds + S2_K + buf * S2_TILE + o) = r.k0; *(u32x4*)(lds + S2_K + buf * S2_TILE + 64 * KP * 2 + o) = r.k1;
    *(u32x4*)(lds + S2_V + buf * S2_TILE + o) = r.v0; *(u32x4*)(lds + S2_V + buf * S2_TILE + 64 * KP * 2 + o) = r.v1;
}
__device__ __forceinline__ void slc_item(const bf16_t* Z, const unsigned* SELMASK, bf16_t* Y, unsigned char* lds, int bg, int qt, float dsc) {
    const int tid = tidx(), lane = tid & 63, wave = tid >> 6, r32 = lane & 31, h = lane >> 5;
    const int b_ = bg >> 1, g = bg & 1, tl = r32 >> 2, hr = r32 & 3;
    const int t = 64 * qt + 8 * wave + tl;
    const unsigned tok = (unsigned)(b_ * SEQ + t);
    const float* bt = (const float*)(lds + OFF_BT) + (g * 4 + hr) * BTP;
    float* wsf = (float*)(lds + S2_WS + wave * 256);
    const ldsp KL = (ldsp)lds + S2_K + (r32 * KP + 8 * h) * 2;
    const ldsp VL = (ldsp)lds + S2_V + ((4 * h + ((lane & 15) >> 2)) * KP + 16 * ((lane >> 4) & 1) + 4 * (lane & 3)) * 2;
    bf16x8 qf[4]; load_q(qf, Z + (tok * ZLD + ZC_NQ + g * 256 + hr * 64 + 8 * h));
    const u32x4 mk = *(const u32x4*)(SELMASK + (unsigned)((bg * SEQ + t) * 4));
    const float bfar = bt[1023];
    f32x16 o[2] = {splat16(0.f), splat16(0.f)};
    float m = 0.f, l = 0.f;
    const bf16_t* ksl = Z + (unsigned)(b_ * SEQ * ZLD + ZC_NKV + 2 * 128 + g * 64); const bf16_t* vsl = ksl + 128;
    const int rmax = 64 * qt + 63, nstep = (qt >> 1) + 1;
    TileRegs2 tr; int buf = 0;
    tile_load2(tr, ksl, vsl, 0, rmax);
    for (int st = 0; st < nstep; ++st) {
        tile_store2(lds, buf, tr); __syncthreads();
        if (st + 1 < nstep) tile_load2(tr, ksl, vsl, 128 * (st + 1), rmax);
#pragma unroll
        for (int hb = 0; hb < 2; ++hb) {
            const int j = 2 * st + hb;
            if (j > qt) break;
            const int jw = j >> 5;
            const unsigned mw = jw == 0 ? mk.x : (jw == 1 ? mk.y : (jw == 2 ? mk.z : mk.w));
            const bool sel = (mw >> (j & 31)) & 1u;
            if (!__any(sel)) continue;
            const ldsp Kt = KL + buf * S2_TILE + hb * 64 * KP * 2;
            const ldsp Vt = VL + buf * S2_TILE + hb * 64 * KP * 2;
            const bool near = (qt - j) < 14;
            const f32x16 ci = splat16(sel ? (near ? 0.f : bfar) - m : -1e30f);
            f32x16 s0 = qk32(Kt, qf, ci, r32, h), s1 = qk32(Kt + 32 * KP * 2, qf, ci, r32, h);
            if (near) {
                const int db = t - 64 * j - 4 * h;
                if (j == qt) {
#pragma unroll
                    for (int i = 0; i < 16; ++i) { const int co = (i & 3) + 8 * (i >> 2); const int d0 = db - co, d1 = db - 32 - co;
                        s0[i] = d0 >= 0 ? s0[i] + bt[min((unsigned)d0, 1023u)] : -1e30f; s1[i] = d1 >= 0 ? s1[i] + bt[min((unsigned)d1, 1023u)] : -1e30f; }
                } else {
#pragma unroll
                    for (int i = 0; i < 16; ++i) { const int co = (i & 3) + 8 * (i >> 2); s0[i] += bt[min(db - co, 1023)]; s1[i] += bt[min(db - 32 - co, 1023)]; }
                }
            }
            softmax_rel(o, m, l, s0, s1, Vt, wsf, lane);
        }
        buf ^= 1;
    }
    l = swapadd(l);
    scale_rows(o, dsc * gate_of(Z + tok * ZLD, g, hr, 1) / fmaxf(l, 1e-30f), wsf, lane);
    const unsigned yo = (unsigned)((b_ * SEQ + 64 * qt + 8 * wave + h) * DM + 512 + g * 256 + r32);
#pragma unroll
    for (int i = 0; i < 16; ++i) {
        const int ci = (i & 3) + 8 * (i >> 2);
        const unsigned oo = yo + (unsigned)((ci >> 2) * DM + (ci & 3) * 64);
        Y[oo] = f2bf(bf2f(Y[oo]) + o[0][i]); Y[oo + 32] = f2bf(bf2f(Y[oo + 32]) + o[1][i]);
    }
    __syncthreads();
}
}


namespace cmpr {
typedef short bf16x8 __attribute__((ext_vector_type(8)));
constexpr int OFF_PART = 0, OFF_HID = 32768, CMPR_LDS = OFF_HID + 16 * 72 * 2;
__device__ __forceinline__ void item(const bf16_t* Z, const bf16_t* W1t, const bf16_t* W2t, const float* posb, bf16_t* OUT, unsigned char* lds, int bg, int kv, int nt) {
    const int tid = tidx(), lane = tid & 63, wave = tid >> 6, row = lane & 15, kq = lane >> 4;
    const int b_ = bg >> 1, g = bg & 1, n = 16 * nt + row;
    f32x4 acc[4];
#pragma unroll
    for (int mt = 0; mt < 4; ++mt) acc[mt] = (f32x4){0.f, 0.f, 0.f, 0.f};
    const unsigned zbase = (unsigned)(b_ * SEQ * ZLD + ZC_NKV + kv * 128 + g * 64 + 8 * kq);
#pragma unroll
    for (int kk = 0; kk < 8; ++kk) {
        const int ks = 8 * wave + kk;
        const int tok = min(16 * n + (ks >> 1), SEQ - 1);
        const bf16x8 a = *(const bf16x8*)(Z + (zbase + (unsigned)(tok * ZLD + 32 * (ks & 1))));
#pragma unroll
        for (int mt = 0; mt < 4; ++mt) {
            const bf16x8 bq = *(const bf16x8*)(W1t + (unsigned)((16 * mt + row) * 2048 + 32 * ks + 8 * kq));
            acc[mt] = __builtin_amdgcn_mfma_f32_16x16x32_bf16(a, bq, acc[mt], 0, 0, 0);
        }
    }
    float* part = (float*)(lds + OFF_PART) + wave * 1024;
#pragma unroll
    for (int mt = 0; mt < 4; ++mt)
#pragma unroll
        for (int r = 0; r < 4; ++r) part[(4 * kq + r) * 64 + 16 * mt + row] = acc[mt][r];
    __syncthreads();
    bf16_t* hid = (bf16_t*)(lds + OFF_HID);
    {
        const int nn = tid >> 5, m2 = (tid & 31) * 2;
        float s0 = 0.f, s1 = 0.f;
#pragma unroll
        for (int w = 0; w < 8; ++w) { const float2 v = *(const float2*)((const float*)(lds + OFF_PART) + w * 1024 + nn * 64 + m2); s0 += v.x; s1 += v.y; }
        *(unsigned*)(hid + nn * 72 + m2) = pg8::cvt_pk_bf16(gelu_tanh(s0 + posb[m2]), gelu_tanh(s1 + posb[m2 + 1]));
    }
    __syncthreads();
    if (wave < 4) {
        const int et = wave;
        f32x4 o = (f32x4){0.f, 0.f, 0.f, 0.f};
#pragma unroll
        for (int ks = 0; ks < 2; ++ks) {
            const bf16x8 a = *(const bf16x8*)(lds + OFF_HID + (row * 72 + 32 * ks + 8 * kq) * 2);
            const bf16x8 bq = *(const bf16x8*)(W2t + (16 * et + row) * 64 + 32 * ks + 8 * kq);
            o = __builtin_amdgcn_mfma_f32_16x16x32_bf16(a, bq, o, 0, 0, 0);
        }
#pragma unroll
        for (int r = 0; r < 4; ++r) { const int nn = 16 * nt + 4 * kq + r; OUT[(unsigned)((bg * 512 + nn) * 64 + 16 * et + row)] = (nn < NCMP) ? f2bf(o[r]) : (bf16_t)0; }
    }
    __syncthreads();
}
}
#define LAS __attribute__((address_space(3)))
#define XB_TMO      128
#define XB_XCNT(j)  (256  + 64 * (j))
#define XB_XSUB(j)  (1280 + 64 * (j))
#define XB_XGEN(j)  (2304 + 64 * (j))
#define XB_TOP      3328
#define XB_TOPGEN   3392
#define XCD_BAR_WORDS 3456
#define XB_SPIN_CAP (1u << 18)

__device__ __forceinline__ unsigned xb_ld(unsigned* p)              { return __hip_atomic_load(p, __ATOMIC_RELAXED, __HIP_MEMORY_SCOPE_AGENT); }
__device__ __forceinline__ unsigned xb_add(unsigned* p, unsigned v) { return __hip_atomic_fetch_add(p, v, __ATOMIC_RELAXED, __HIP_MEMORY_SCOPE_AGENT); }
__device__ __forceinline__ unsigned xb_xcc_id() { return (unsigned)__builtin_amdgcn_s_getreg((3 << 11) | 20) & 0xFu; }
#define XB_SPIN(cond, bar) do { unsigned _sp = 0; while (cond) { __builtin_amdgcn_s_sleep(1); \
    if ((++_sp & 255u) == 0u) { if (xb_ld(&(bar)[XB_TMO])) break; if (_sp > XB_SPIN_CAP) { atomicAdd(&(bar)[XB_TMO], 1u); break; } } } } while (0)

struct XcdBarrier {
    unsigned* bar; unsigned x;
    volatile LAS unsigned* st;
};

__device__ __forceinline__ XcdBarrier xcd_barrier_post(unsigned* bar, volatile LAS unsigned* st) {
    XcdBarrier b; b.bar = bar; b.x = xb_xcc_id(); b.st = st;
    if (threadIdx.x == 0) (void)xb_add(&bar[XB_XCNT(b.x)], 1u);
    return b;
}
__device__ __forceinline__ void xcd_barrier_complete(unsigned* bar, unsigned x, unsigned& nloc, unsigned& nx) {
    const unsigned G = gridDim.x * gridDim.y * gridDim.z;
    unsigned sum, cnt, mine, sp = 0u;
    for (;;) {
        sum = 0u; cnt = 0u; mine = 0u;
#pragma unroll
        for (unsigned j = 0; j < 16; ++j) { const unsigned c = xb_ld(&bar[XB_XCNT(j)]); sum += c; cnt += (c > 0u) ? 1u : 0u; mine = (j == x) ? c : mine; }
        if (sum == G) break;
        __builtin_amdgcn_s_sleep(1);
        if ((++sp & 255u) == 0u) { if (xb_ld(&bar[XB_TMO])) break; if (sp > XB_SPIN_CAP) { atomicAdd(&bar[XB_TMO], 1u); break; } }
    }
    nloc = mine > 0u ? mine : 1u; nx = cnt > 0u ? cnt : 1u;
}

__device__ __forceinline__ void xcd_barrier(const XcdBarrier& b) {
    asm volatile("s_waitcnt vmcnt(0)" ::: "memory");
    __syncthreads();
    if (threadIdx.x == 0) {
        unsigned* bar = b.bar;
        __builtin_amdgcn_s_waitcnt(0);
        unsigned nloc = b.st[0], nx = b.st[1];
        if (nloc == 0u) { xcd_barrier_complete(bar, b.x, nloc, nx); b.st[0] = nloc; b.st[1] = nx; }
        const unsigned old = xb_add(&bar[XB_XSUB(b.x)], 1u);
        const unsigned gen = old / nloc;
        if (old + 1u == (gen + 1u) * nloc) {
            __builtin_amdgcn_fence(__ATOMIC_RELEASE, "agent");
            asm volatile("s_waitcnt vmcnt(0)" ::: "memory");
            const unsigned og = xb_add(&bar[XB_TOP], 1u);
            const unsigned tg = og / nx;
            if (og + 1u == (tg + 1u) * nx) xb_add(&bar[XB_TOPGEN], 1u);
            else XB_SPIN(xb_ld(&bar[XB_TOPGEN]) == tg, bar);
            __builtin_amdgcn_fence(__ATOMIC_ACQUIRE, "agent");
            xb_add(&bar[XB_XGEN(b.x)], 1u);
            asm volatile("s_waitcnt vmcnt(0)" ::: "memory");
        } else {
            XB_SPIN(xb_ld(&bar[XB_XGEN(b.x)]) == gen, bar);
            __builtin_amdgcn_fence(__ATOMIC_ACQUIRE, "agent");
            asm volatile("s_waitcnt vmcnt(0)" ::: "memory");
        }
    }
    __syncthreads();
}

template <int L, int WHICH>
__device__ __forceinline__ void convert_group(const Params& p, float* lds, int wrank, int nwaves) {
    unsigned char* wl = p.ws + WS_W + L * W_LAYER;
    int cwg = wrank; const int NGW = nwaves;
    if constexpr (WHICH == 0) {
        convert_wt(p.in[2] + (size_t)L * DM * DFF, DM, DFF, p.in[1] + L * DM, (bf16_t*)(wl + W_GU1), 0, 0, lds, cwg, NGW);
        convert_wt(p.in[3] + (size_t)L * DM * DFF, DM, DFF, p.in[1] + L * DM, (bf16_t*)(wl + W_GU1), 0, 128, lds, cwg, NGW);
        convert_wt(p.in[4] + (size_t)L * DM * DFF, DFF, DM, nullptr, (bf16_t*)(wl + W_D1), 1, 0, lds, cwg, NGW);
    } else {
        convert_wt(p.in[6] + (size_t)L * DM * DIN, DM, DIN, p.in[5] + L * DM, (bf16_t*)(wl + W_IN), 1, 0, lds, cwg, NGW);
        convert_wt(p.in[7] + (size_t)L * DM * DM, DM, DM, nullptr, (bf16_t*)(wl + W_OUT), 1, 0, lds, cwg, NGW);
        convert_wt(p.in[27] + (size_t)L * DM * DFF, DM, DFF, p.in[26] + L * DM, (bf16_t*)(wl + W_GU2), 0, 0, lds, cwg, NGW);
        convert_wt(p.in[28] + (size_t)L * DM * DFF, DM, DFF, p.in[26] + L * DM, (bf16_t*)(wl + W_GU2), 0, 128, lds, cwg, NGW);
        convert_wt(p.in[29] + (size_t)L * DM * DFF, DFF, DM, nullptr, (bf16_t*)(wl + W_D2), 1, 0, lds, cwg, NGW);
        bf16_t* win = (bf16_t*)(wl + W_IN);
        for (int i = wrank * 64 + (tidx() & 63); i < (ZLD - DIN) * DM; i += nwaves * 64) win[DIN * DM + i] = 0;
    }
}

constexpr int ST_PER_LAYER = 10, NSTAGES = 1 + 2 * ST_PER_LAYER + 1;

template <class Epi, bool LDAK = true>
__device__ __forceinline__ void gemm_stage(float* lds, const bf16_t* A, const bf16_t* Bt, int N, int K, const Epi& E, int lda = 0) {
    pg8::Gemm g{A, Bt, MTOK, N, K, lda ? lda : K};
    pg8::StaticOrder S; S.init(MTOK, N, (int)gridDim.x, (int)blockIdx.x);
    pg8::gemm_phase<Epi, pg8::StaticOrder, true, true, LDAK>((PG8_LAS unsigned char*)lds, g, S, E);
}

template <int st>
__device__ __forceinline__ void run_stage(const Params& p, float* lds, float dsc = 1.0f) {
    const int bid = blockIdx.x, nb = gridDim.x, tid = tidx(), wave = tid >> 6;
    unsigned char* ws = p.ws;
    float* SSQ = (float*)(ws + WS_SMALL + SM_SSQ);
    float* LB = (float*)(ws + WS_SMALL + SM_LB);
    bf16_t* KC = (bf16_t*)(ws + WS_SMALL + SM_KC);
    bf16_t* VC = (bf16_t*)(ws + WS_SMALL + SM_VC);
    bf16_t* XB = (bf16_t*)(ws + WS_XB);
    unsigned char* msc = (unsigned char*)p.X;
    bf16_t* HZ = (bf16_t*)(ws + WS_HZ);
    bf16_t* Y = (bf16_t*)(ws + WS_Y);
    if constexpr (st == 0) {
        const int NGW = nb * NWAVE; int cwg = bid * NWAVE + wave;
        convert_group<0, 0>(p, lds, cwg, NGW);
        cwg = bid * NWAVE + wave;
        for (int l = 0; l < 2; ++l) {
            s5_tables(p, l, (float*)(ws + WS_SMALL + SM_S5AB + l * SM_S5_LAYER), bid * NT + tid, nb * NT);
            convert_wt(p.in[16] + (size_t)l * 65536, 256, 256, nullptr, (bf16_t*)(ws + WS_SMALL + SM_WGLU) + l * 65536, 1, 0, lds, cwg, NGW);
            for (int kv = 0; kv < 2; ++kv) {
                convert_wt(p.in[kv ? 23 : 20] + (size_t)l * 131072, 2048, 64, nullptr, (bf16_t*)(ws + WS_SMALL + SM_W1T) + (l * 2 + kv) * 131072, 1, 0, lds, cwg, NGW);
                convert_wt(p.in[kv ? 24 : 21] + (size_t)l * 4096, 64, 64, nullptr, (bf16_t*)(ws + WS_SMALL + SM_W2T) + (l * 2 + kv) * 4096, 1, 0, lds, cwg, NGW);
            }
            for (int i = bid * NWAVE + wave; i < 128; i += nb * NWAVE) {
                const int kv = i >> 6, m = i & 63, ln = tid & 63; const float* pos = p.in[kv ? 22 : 19] + l * 2048; const float* w1 = p.in[kv ? 23 : 20] + (size_t)l * 131072;
                float a = 0.f;
#pragma unroll 8
                for (int q = ln; q < 2048; q += 64) a += pos[q] * w1[(size_t)q * 64 + m];
                a = wave_sum(a);
                if (ln == 0) ((float*)(ws + WS_SMALL + SM_POSB))[(l * 2 + kv) * 64 + m] = a;
            }
        }
        s5::pow_table(p, (float*)(ws + WS_POW), bid * NT + tid, nb * NT);
        for (int i = bid * NT + tid; i < 256; i += nb * NT) {
            const float a = p.in[17][i], bq = p.in[17][256 + i], mx = fmaxf(a, bq);
            const float ea = expf(a - mx), eb = expf(bq - mx);
            LB[i] = 0.f; LB[256 + i] = eb / (ea + eb);
        }
        rowstats(p.in[0], const_cast<float*>(p.in[0]), XB, SSQ, bid, nb);
        __syncthreads();
        return;
    }
    if constexpr (st == NSTAGES - 1) { final_norm(p.X, SSQ, p.in[30], bid, nb); return; }
    constexpr int l = (st - 1) / ST_PER_LAYER, s = (st - 1) % ST_PER_LAYER;
    unsigned char* wl = ws + WS_W + l * W_LAYER;
    if constexpr (s == 0) {
        if constexpr (l == 0) {
            for (int ll = 0; ll < 2; ++ll) {
                s5::build_tables(p, ll, (const float*)(ws + WS_POW), (const float*)(ws + WS_SMALL + SM_S5AB + ll * SM_S5_LAYER), ws + WS_S5T + (size_t)ll * s5::T_LAYER, bid * NT + tid, nb * NT);
                for (int i = bid * NT + tid; i < 1024; i += nb * NT) { const float* pw = (const float*)(ws + WS_POW) + ((size_t)((ll * 16 + (i >> 6)) * 65 + 64) * 64 + (i & 63)) * 2; float* a64 = (float*)(ws + WS_SMALL + SM_A64) + (ll * 1024 + i) * 2; a64[0] = pw[0]; a64[1] = pw[1]; }
            }
        }
        gemm_stage(lds, XB, (const bf16_t*)(wl + W_GU1), 2 * DFF, DM, pg8::EpiGU{SSQ, HZ, DFF});
        if constexpr (l == 0) { if (nb == 256 && bid >= 128) convert_group<0, 1>(p, lds, (bid - 128) * NWAVE + wave, 128 * NWAVE); else if (nb != 256) convert_group<0, 1>(p, lds, bid * NWAVE + wave, nb * NWAVE); }
    }
    if constexpr (s == 1) gemm_stage(lds, HZ, (const bf16_t*)(wl + W_D1), DM, DFF, pg8::EpiResB<(l == 0), false>{p.in[0], p.X, XB, SSQ, 0.5f * dsc});
    if constexpr (s == 2) {
        gemm_stage(lds, XB, (const bf16_t*)(wl + W_IN), ZLD, DM, pg8::EpiZ{SSQ, HZ, ZLD});
        if constexpr (l == 0) { if (nb == 256 && bid >= 192) convert_group<1, 0>(p, lds, (bid - 192) * NWAVE + wave, 64 * NWAVE); else if (nb != 256) convert_group<1, 0>(p, lds, bid * NWAVE + wave, nb * NWAVE); }
    }
    if constexpr (s == 3) {
        for (int item = bid; item < 256; item += nb) s5::phase1(HZ, ws + WS_S5T + (size_t)l * s5::T_LAYER, (float*)(msc + WS_S5_XE), (unsigned char*)lds, item);
        for (int item = bid; item < 1024; item += nb) hg::phase1(HZ, LB + l * 256, (float*)(msc + WS_HG_DS), (float*)(msc + WS_HG_GAM), (unsigned char*)lds, item);
        for (int item = bid; item < 256; item += nb) {
            const int nt = item & 31, kv = (item >> 5) & 1, bg = item >> 6;
            cmpr::item(HZ, (const bf16_t*)(ws + WS_SMALL + SM_W1T) + (l * 2 + kv) * 131072, (const bf16_t*)(ws + WS_SMALL + SM_W2T) + (l * 2 + kv) * 4096,
                       (const float*)(ws + WS_SMALL + SM_POSB) + (l * 2 + kv) * 64, kv ? VC : KC, (unsigned char*)lds, bg, kv, nt);
        }
        __syncthreads();
    }
    if constexpr (s == 4) {
        if (bid < 64) hg::phase2((const float*)(msc + WS_HG_DS), (const float*)(msc + WS_HG_GAM), (bf16_t*)(msc + WS_HG_ST), bid * NT + tid);
        if (bid >= 64 && bid < 68) s5::phase2((const float*)(msc + WS_S5_XE), (const float*)(ws + WS_SMALL + SM_A64) + l * 2048, (bf16_t*)(msc + WS_S5_XC), (bid - 64) * NT + tid);
        nsa::fill_btab(p.in[25], (unsigned char*)lds);
        __syncthreads();
        for (int w = bid; w < 256; w += nb) {
            const int bg = (w & 7) >> 1, i = ((w & 1) << 5) | (w >> 3);
            for (int rep = 0; rep < 2; ++rep) nsa::cmpwin_item(HZ, KC, VC, (unsigned*)(msc + WS_SELMASK), Y, (unsigned char*)lds, bg, rep ? 127 - i : i);
        }
    }
    if constexpr (s == 5) {
        for (int item = bid; item < 256; item += nb) s5::phase3(p, l, HZ, ws + WS_S5T + (size_t)l * s5::T_LAYER, (const bf16_t*)(msc + WS_S5_XC), Y, (unsigned char*)lds, item);
        for (int item = bid; item < 1024; item += nb) hg::phase3(HZ, LB + l * 256, p.in[18] + l * 64, (const bf16_t*)(msc + WS_HG_ST), Y, (unsigned char*)lds, item);
        nsa::fill_btab(p.in[25], (unsigned char*)lds);
        __syncthreads();
        for (int w = bid; w < 256; w += nb) {
            const int bg = (w & 7) >> 1, i = ((w & 1) << 5) | (w >> 3);
            for (int rep = 0; rep < 2; ++rep) nsa::slc_item(HZ, (const unsigned*)(msc + WS_SELMASK), Y, (unsigned char*)lds, bg, rep ? 127 - i : i, dsc);
        }
    }
    if constexpr (s == 6) gemm_stage<pg8::EpiGLU, false>(lds, Y, (const bf16_t*)(ws + WS_SMALL + SM_WGLU) + l * 65536, 256, 256, pg8::EpiGLU{Y}, DM);
    if constexpr (s == 7) gemm_stage(lds, Y, (const bf16_t*)(wl + W_OUT), DM, DM, pg8::EpiResB<false, false>{nullptr, p.X, XB, SSQ, 1.0f * dsc});
    if constexpr (s == 8) {
        gemm_stage(lds, XB, (const bf16_t*)(wl + W_GU2), 2 * DFF, DM, pg8::EpiGU{SSQ, HZ, DFF});
        if constexpr (l == 0) { if (nb == 256 && bid >= 128) convert_group<1, 1>(p, lds, (bid - 128) * NWAVE + wave, 128 * NWAVE); else if (nb != 256) convert_group<1, 1>(p, lds, bid * NWAVE + wave, nb * NWAVE); }
    }
    if constexpr (s == 9) gemm_stage(lds, HZ, (const bf16_t*)(wl + W_D2), DM, DFF, pg8::EpiResB<false, (l == 1)>{nullptr, p.X, XB, SSQ, 0.5f * dsc});
}

template <int ST>
__device__ __forceinline__ void run_all(const Params& p, float* lds, cg::grid_group& grid, const XcdBarrier& bar) {
#ifdef DUP_ST
    if (ST == DUP_ST) { run_stage<ST>(p, lds, 0.0f); xcd_barrier(bar); }
#endif
    if (p.st_lo <= ST && ST < p.st_hi) {
        run_stage<ST>(p, lds);
        if (ST + 1 < p.st_hi) { if (p.st_hi < 0) grid.sync(); else xcd_barrier(bar); }
    }
    if constexpr (ST + 1 < NSTAGES) run_all<ST + 1>(p, lds, grid, bar);
}

__global__ void __launch_bounds__(NT, 2) fwd_kernel(Params p) {
    extern __shared__ __attribute__((aligned(16))) unsigned char lds_raw[];
    cg::grid_group grid = cg::this_grid();
    float* lds = (float*)lds_raw;
    volatile LAS unsigned* bst = (volatile LAS unsigned*)((LAS unsigned char*)lds_raw + LDS_BYTES - 64);
    if (tidx() < 16) bst[tidx()] = 0u;
    __syncthreads();
    const XcdBarrier bar = xcd_barrier_post((unsigned*)(p.ws + WS_CTL) + 1024, bst);
    run_all<0>(p, lds, grid, bar);
}

extern "C" void kernel_launch(void* const* d_in, const int* in_sizes, int n_in,
                              void* d_out, int out_size, void* d_ws, size_t ws_size,
                              hipStream_t stream) {
    static int grid_blocks = 0;
    if (!grid_blocks) {
        int dev = 0, cus = 0, per_cu = 0;
        (void)hipGetDevice(&dev);
        (void)hipDeviceGetAttribute(&cus, hipDeviceAttributeMultiprocessorCount, dev);
        (void)hipFuncSetAttribute((const void*)fwd_kernel, hipFuncAttributeMaxDynamicSharedMemorySize, LDS_BYTES);
        (void)hipOccupancyMaxActiveBlocksPerMultiprocessor(&per_cu, (const void*)fwd_kernel, NT, LDS_BYTES);
        if (per_cu < 1) { fprintf(stderr, "occupancy query says %d blocks/CU\n", per_cu); per_cu = 1; }
        grid_blocks = cus;
        if (ws_size < WS_END) fprintf(stderr, "workspace too small: %zu < %zu\n", ws_size, (size_t)WS_END);
    }
    Params p{};
    for (int i = 0; i < 31; ++i) p.in[i] = (const float*)d_in[i];
    p.X = (float*)d_out; p.ws = (unsigned char*)d_ws; p.st_lo = 0; p.st_hi = NSTAGES;
    (void)hipMemsetAsync((char*)d_ws + WS_CTL, 0, 65536, stream);
    void* args[] = {&p};
    hipError_t e = hipLaunchCooperativeKernel((void*)fwd_kernel, dim3(grid_blocks), dim3(NT), args, LDS_BYTES, stream);
    if (e != hipSuccess) fprintf(stderr, "cooperative launch failed: %s (grid %d)\n", hipGetErrorString(e), grid_blocks);
}
```
